# Optimizing an MI355X kernel written in HIP

```python
import math, functools
import jax, jax.numpy as jnp
from jax import lax
import numpy as np

D_MODEL = 1024
BATCH = 1
SEQ = 16384
DEPTH = 2
DEC_BATCH = 32
DEC_SEQ = 64
PAST_LEN = 4096

CHUNK = 64
HEAD_DIM = 64
A_HEADS = 4
A_DK = 64
A_DV = 128
A_GATE_RANK = 16
A_GATE_TAU = 16.0
B_HEADS = 4
B_KV_HEADS = 2
B_WINDOW = 128
B_PREV_CHUNKS = B_WINDOW // CHUNK
C_HEADS = 4
C_PREV_CHUNKS = 8
C_BAND = C_PREV_CHUNKS * CHUNK
C_CLIP = 256
T5_BUCKETS = 32
T5_MAX_DIST = 128
D_FF = 4 * D_MODEL
D_MIX = A_HEADS * A_DV + B_HEADS * HEAD_DIM + C_HEADS * HEAD_DIM
SPLIT_SIZES = (A_HEADS * A_DK, A_HEADS * A_DK, A_HEADS * A_DV, A_HEADS * A_DV, A_GATE_RANK,
               B_HEADS * HEAD_DIM, B_KV_HEADS * HEAD_DIM, B_KV_HEADS * HEAD_DIM,
               C_HEADS * HEAD_DIM, C_HEADS * HEAD_DIM, C_HEADS * HEAD_DIM)
D_IN = sum(SPLIT_SIZES)
NORM_EPS = 1e-6
NEG_INF = -1e30

kernel_name = 'hybrid_streaming_encoder_step'


def rms_norm(x, g):
    x32 = x.astype(jnp.float32)
    y = x32 * lax.rsqrt(jnp.mean(x32 * x32, axis=-1, keepdims=True) + NORM_EPS)
    return (y * g.astype(jnp.float32)).astype(x.dtype)


def modulate(x, g, shift, scale):
    return rms_norm(x, g) * (1 + scale[:, None, :]) + shift[:, None, :]


def split_offsets():
    offs, t = [], 0
    for s in SPLIT_SIZES[:-1]:
        t += s
        offs.append(t)
    return offs


def project_heads(h, w_in, w_a2, b_a2):
    B_, T, _ = h.shape
    qa, ka, va, ga, ra, qb, kb, vb, qc, kc, vc = jnp.split(h @ w_in, split_offsets(), axis=-1)
    la = jax.nn.log_sigmoid((ra @ w_a2 + b_a2).astype(jnp.float32)) / A_GATE_TAU
    heads = lambda t, n: t.reshape(B_, T, n, -1)
    return (heads(qa, A_HEADS) * (A_DK ** -0.5), heads(ka, A_HEADS), heads(va, A_HEADS), ga,
            heads(la, A_HEADS),
            heads(qb, B_HEADS), heads(kb, B_KV_HEADS), heads(vb, B_KV_HEADS),
            heads(qc, C_HEADS), heads(kc, C_HEADS), heads(vc, C_HEADS))


def gla_chunk(S, q, k, v, la):
    L = q.shape[2]
    b = jnp.cumsum(la, axis=2)
    causal = jnp.tril(jnp.ones((L, L), dtype=bool))
    diff = b[:, :, :, None, :] - b[:, :, None, :, :]
    decay = jnp.exp(jnp.where(causal[None, None, :, :, None], diff, -jnp.inf))
    attn = jnp.einsum('bhtd,bhsd,bhtsd->bhts', q, k, decay)
    o = jnp.einsum('bhts,bhsv->bhtv', attn, v) + jnp.einsum('bhtd,bhdv->bhtv', q * jnp.exp(b), S)
    b_last = b[:, :, -1:, :]
    S_new = jnp.exp(b_last[:, :, 0, :])[..., None] * S + jnp.einsum('bhsd,bhsv->bhdv', k * jnp.exp(b_last - b), v)
    return S_new, o


def gla_prompt(q, k, v, la):
    B_, T, H, dk = q.shape
    dv = v.shape[-1]
    nc = T // CHUNK
    to_blocks = lambda t: t.astype(jnp.float32).reshape(B_, nc, CHUNK, H, t.shape[-1]).transpose(1, 0, 3, 2, 4)
    S0 = jnp.zeros((B_, H, dk, dv), jnp.float32)
    S, o = lax.scan(lambda S, inp: gla_chunk(S, *inp), S0, (to_blocks(q), to_blocks(k), to_blocks(v), to_blocks(la)))
    return S, o.transpose(1, 0, 3, 2, 4).reshape(B_, T, H, dv)


def gla_sample(S, q, k, v, la):
    tr = lambda t: t.astype(jnp.float32).transpose(0, 2, 1, 3)
    S_new, o = gla_chunk(S.astype(jnp.float32), tr(q), tr(k), tr(v), tr(la))
    return S_new, o.transpose(0, 2, 1, 3)


def gla_output(o, g, norm_g):
    B_, T, H, dv = o.shape
    on = rms_norm(o, norm_g)
    return (on * jax.nn.silu(g.astype(jnp.float32)).reshape(B_, T, H, dv)).reshape(B_, T, H * dv)


def t5_bucket(rel):
    half = T5_BUCKETS // 2
    max_exact = half // 2
    n = jnp.abs(rel)
    log_ratio = jnp.log(jnp.maximum(n, 1).astype(jnp.float32) / max_exact) / math.log(T5_MAX_DIST / max_exact)
    large = jnp.minimum(max_exact + (log_ratio * (half - max_exact)).astype(jnp.int32), half - 1)
    return jnp.where(rel > 0, half, 0) + jnp.where(n < max_exact, n, large)


def t5_logits(table, rel):
    return jnp.moveaxis(table[t5_bucket(rel)], -1, 1).astype(jnp.float32)


def clipped_logits(table, rel):
    return jnp.moveaxis(table[jnp.clip(rel, -C_CLIP, C_CLIP) + C_CLIP], -1, 1).astype(jnp.float32)


def band_attention(q, k, v, bias, valid, sink):
    B_, N, Lq, H, hd = q.shape
    Lk, G = k.shape[2], k.shape[3]
    R = H // G
    qg = q.reshape(B_, N, Lq, G, R, hd)
    s = jnp.einsum('bnqgrd,bnkgd->bngrqk', qg, k).astype(jnp.float32) * (hd ** -0.5)
    s = s + bias.reshape(bias.shape[0], G, R, Lq, Lk)[None]
    s = jnp.where(valid[None, :, None, None, None, :], s, NEG_INF)
    if sink is None:
        p = jax.nn.softmax(s, axis=-1)
    else:
        sk = sink.astype(jnp.float32).reshape(G, R)[None, None, :, :, None, None]
        m = jnp.maximum(jnp.max(s, axis=-1, keepdims=True), sk)
        e = jnp.exp(s - m)
        p = e / (jnp.sum(e, axis=-1, keepdims=True) + jnp.exp(sk - m))
    o = jnp.einsum('bngrqk,bnkgd->bnqgrd', p.astype(v.dtype), v)
    return o.reshape(B_, N, Lq, H * hd)


def chunk_band(x, n_prev):
    B_, T = x.shape[:2]
    nc = T // CHUNK
    xc = x.reshape(B_, nc, CHUNK, x.shape[2], x.shape[3])
    xp = jnp.pad(xc, ((0, 0), (n_prev, 0), (0, 0), (0, 0), (0, 0)))
    return jnp.concatenate([xp[:, i:i + nc] for i in range(n_prev + 1)], axis=2)


def attend_prompt(q, k, v, n_prev, bias_fn, sink):
    B_, T, H, hd = q.shape
    nc = T // CHUNK
    lk = (n_prev + 1) * CHUNK
    kpos = jnp.arange(lk) - n_prev * CHUNK
    rel = (kpos[None, :] - jnp.arange(CHUNK)[:, None])[None]
    valid = (jnp.arange(nc)[:, None] * CHUNK + kpos[None, :]) >= 0
    o = band_attention(q.reshape(B_, nc, CHUNK, H, hd), chunk_band(k, n_prev), chunk_band(v, n_prev),
                       bias_fn(rel), valid, sink)
    return o.reshape(B_, T, H * hd)


def attend_sample(q, k_new, v_new, k_cache, v_cache, bias_fn, sink):
    B_, S = q.shape[:2]
    Lc = k_cache.shape[1]
    k = jnp.concatenate([k_cache.astype(k_new.dtype), k_new], axis=1)
    v = jnp.concatenate([v_cache.astype(v_new.dtype), v_new], axis=1)
    lk = Lc + S
    rel = ((jnp.arange(lk) - Lc)[None, :] - jnp.arange(S)[:, None])[None]
    valid = jnp.ones((1, lk), dtype=bool)
    o = band_attention(q[:, None], k[:, None], v[:, None], bias_fn(rel), valid, sink)
    return o.reshape(B_, S, -1), k[:, -Lc:], v[:, -Lc:]


def run_trunk(x, c, state_gla, cache_b_k, cache_b_v, cache_c_k, cache_c_v,
              w_ada, b_ada, norm_mix_g, norm_mlp_g, w_in, w_a2, b_a2, a_norm_g, b_sink, t5_bias,
              c_rel_bias, w_out, w_up, w_down, final_norm_g):
    is_prompt = state_gla is None
    T = x.shape[1]
    new_gla, new_kb, new_vb, new_kc, new_vc = [], [], [], [], []
    t5_fn = functools.partial(t5_logits, t5_bias)
    for l in range(DEPTH):
        sh_m, sc_m, gt_m, sh_f, sc_f, gt_f = jnp.split(jax.nn.silu(c) @ w_ada[l] + b_ada[l], 6, axis=-1)
        h = modulate(x, norm_mix_g[l], sh_m, sc_m)
        qa, ka, va, ga, la, qb, kb, vb, qc, kc, vc = project_heads(h, w_in[l], w_a2[l], b_a2[l])
        c_fn = functools.partial(clipped_logits, c_rel_bias[l])
        if is_prompt:
            S, oa = gla_prompt(qa, ka, va, la)
            ob = attend_prompt(qb, kb, vb, B_PREV_CHUNKS, t5_fn, b_sink[l])
            oc = attend_prompt(qc, kc, vc, C_PREV_CHUNKS, c_fn, None)
            lc = min(C_BAND, T)
            kb_buf, vb_buf = kb[:, -B_WINDOW:], vb[:, -B_WINDOW:]
            kc_buf, vc_buf = kc[:, -lc:], vc[:, -lc:]
        else:
            S, oa = gla_sample(state_gla[l], qa, ka, va, la)
            ob, kb_buf, vb_buf = attend_sample(qb, kb, vb, cache_b_k[l], cache_b_v[l], t5_fn, b_sink[l])
            oc, kc_buf, vc_buf = attend_sample(qc, kc, vc, cache_c_k[l], cache_c_v[l], c_fn, None)
        oa = gla_output(oa, ga, a_norm_g[l]).astype(x.dtype)
        mixed = jnp.concatenate([oa, ob, oc], axis=-1) @ w_out[l]
        x = x + gt_m[:, None, :] * mixed
        h = modulate(x, norm_mlp_g[l], sh_f, sc_f)
        x = x + gt_f[:, None, :] * (jnp.square(jax.nn.relu(h @ w_up[l])) @ w_down[l])
        new_gla.append(S.astype(x.dtype))
        new_kb.append(kb_buf)
        new_vb.append(vb_buf)
        new_kc.append(kc_buf)
        new_vc.append(vc_buf)
    y = rms_norm(x, final_norm_g)
    return y, (jnp.stack(new_gla), jnp.stack(new_kb), jnp.stack(new_vb), jnp.stack(new_kc), jnp.stack(new_vc))


def setup_inputs(seed: int = 0) -> dict:
    key = jax.random.key(seed)
    ks = jax.random.split(key, 32)
    nrm = lambda k, shape, scale: jax.random.normal(k, shape, jnp.float32) * scale
    lc = min(C_BAND, PAST_LEN)
    return {
        'x_prompt': nrm(ks[0], (BATCH, SEQ, D_MODEL), 1.0),
        'x_sample': nrm(ks[1], (DEC_BATCH, DEC_SEQ, D_MODEL), 1.0),
        'c_prompt': nrm(ks[2], (BATCH, D_MODEL), 1.0),
        'c_sample': nrm(ks[3], (DEC_BATCH, D_MODEL), 1.0),
        'state_gla': nrm(ks[4], (DEPTH, DEC_BATCH, A_HEADS, A_DK, A_DV), 1.0),
        'cache_b_k': nrm(ks[5], (DEPTH, DEC_BATCH, B_WINDOW, B_KV_HEADS, HEAD_DIM), 1.0),
        'cache_b_v': nrm(ks[6], (DEPTH, DEC_BATCH, B_WINDOW, B_KV_HEADS, HEAD_DIM), 1.0),
        'cache_c_k': nrm(ks[7], (DEPTH, DEC_BATCH, lc, C_HEADS, HEAD_DIM), 1.0),
        'cache_c_v': nrm(ks[8], (DEPTH, DEC_BATCH, lc, C_HEADS, HEAD_DIM), 1.0),
        'w_ada': nrm(ks[9], (DEPTH, D_MODEL, 6 * D_MODEL), 0.5 * D_MODEL ** -0.5),
        'b_ada': nrm(ks[10], (DEPTH, 6 * D_MODEL), 0.01),
        'norm_mix_g': 1.0 + nrm(ks[11], (DEPTH, D_MODEL), 0.05),
        'norm_mlp_g': 1.0 + nrm(ks[12], (DEPTH, D_MODEL), 0.05),
        'w_in': nrm(ks[13], (DEPTH, D_MODEL, D_IN), D_MODEL ** -0.5),
        'w_a2': nrm(ks[14], (DEPTH, A_GATE_RANK, A_HEADS * A_DK), A_GATE_RANK ** -0.5),
        'b_a2': nrm(ks[15], (DEPTH, A_HEADS * A_DK), 0.1),
        'a_norm_g': 1.0 + nrm(ks[16], (DEPTH, A_DV), 0.05),
        'b_sink': nrm(ks[17], (DEPTH, B_HEADS), 1.0),
        't5_bias': nrm(ks[18], (T5_BUCKETS, B_HEADS), 0.5),
        'c_rel_bias': nrm(ks[19], (DEPTH, 2 * C_CLIP + 1, C_HEADS), 0.5),
        'w_out': nrm(ks[20], (DEPTH, D_MIX, D_MODEL), D_MIX ** -0.5),
        'w_up': nrm(ks[21], (DEPTH, D_MODEL, D_FF), D_MODEL ** -0.5),
        'w_down': nrm(ks[22], (DEPTH, D_FF, D_MODEL), D_FF ** -0.5),
        'final_norm_g': 1.0 + nrm(ks[23], (D_MODEL,), 0.05),
    }


def reference(x_prompt, x_sample, c_prompt, c_sample, state_gla, cache_b_k, cache_b_v, cache_c_k, cache_c_v,
              w_ada, b_ada, norm_mix_g, norm_mlp_g, w_in, w_a2, b_a2, a_norm_g, b_sink, t5_bias, c_rel_bias,
              w_out, w_up, w_down, final_norm_g):
    weights = (w_ada, b_ada, norm_mix_g, norm_mlp_g, w_in, w_a2, b_a2, a_norm_g, b_sink, t5_bias,
               c_rel_bias, w_out, w_up, w_down, final_norm_g)
    y_prompt, (sg_p, kb_p, vb_p, kc_p, vc_p) = run_trunk(x_prompt, c_prompt, None, None, None, None, None, *weights)
    y_sample, (sg_s, kb_s, vb_s, kc_s, vc_s) = run_trunk(x_sample, c_sample, state_gla, cache_b_k, cache_b_v,
                                                         cache_c_k, cache_c_v, *weights)
    return (y_prompt, y_sample, sg_p, kb_p, vb_p, kc_p, vc_p, sg_s, kb_s, vb_s, kc_s, vc_s)
```

```cpp
#include <hip/hip_runtime.h>
#include <cstdio>
#include <cstdint>
namespace pg8 {
#define PG8_LAS __attribute__((address_space(3)))
typedef unsigned short bf16_t;
typedef short bf16x8 __attribute__((ext_vector_type(8)));
typedef float f32x4 __attribute__((ext_vector_type(4)));
typedef unsigned u32x4 __attribute__((ext_vector_type(4)));
typedef unsigned u32x2 __attribute__((ext_vector_type(2)));
constexpr int BM = 256, BK = 64, HALF = 128, HTB = HALF * BK * 2  , STAGE_BYTES = 8 * HTB, NXCD = 8, WGM = 8;

__host__ __device__ __forceinline__ int lds_byte(int r, int c) { const int st = (r >> 4) * 2 + (c >> 5), rr = r & 15, cc = c & 31, ob = rr * 64 + cc * 2; return st * 1024 + (ob ^ (((ob >> 9) & 1) << 5)); }
__host__ __device__ __forceinline__ void stage_rc(int b, int& R, int& C) { const int st = b / 1024, sb = b % 1024, swz = sb ^ (((sb >> 9) & 1) << 5); R = (st >> 1) * 16 + swz / 64; C = (st & 1) * 32 + (swz % 64) / 2; }
__host__ __device__ __forceinline__ int perm32(int rho) { const int n = rho >> 4, i = rho & 15; return 8 * (i >> 2) + 4 * n + (i & 3); }

struct Unit { int pm, pn; };
struct Gemm { const bf16_t* A; const bf16_t* Bt; int M, N, K; };

struct StaticOrder {
    int nM, nN, nwg, G, c;
    __host__ __device__ void init(int M, int N, int G_, int c_) { nM = M / BM; nN = N / BM; nwg = nM * nN; G = G_; c = c_; }
    __host__ __device__ bool next(int i, Unit& u) const {
        const long L = (long)i * G + c; if (L >= nwg) return false;
        int wgid = (int)L; { const int q = nwg / NXCD, r = nwg % NXCD, xcd = wgid % NXCD, off = wgid / NXCD; wgid = (xcd < r ? xcd * (q + 1) : r * (q + 1) + (xcd - r) * q) + off; }
        const int nig = WGM * nN, gid = wgid / nig, fm = gid * WGM, gsz = (nM - fm) < WGM ? (nM - fm) : WGM;
        u.pm = fm + ((wgid % nig) % gsz); u.pn = (wgid % nig) / gsz; return true;
    }
    __device__ __forceinline__ void a_ready(const Unit&) const {}
    __device__ __forceinline__ void done(const Unit&) const {}
};

__device__ __forceinline__ unsigned cvt_pk_bf16(float lo, float hi) { unsigned r; asm volatile("v_cvt_pk_bf16_f32 %0, %1, %2" : "=v"(r) : "v"(lo), "v"(hi)); return r; }

constexpr int NTOK_P = 16384, D_MODEL = 1024, PLD = 2816, NMOD = 6144, NIN_PAD = 3072, DFF = 4096;
constexpr float NEPS = 1e-6f;
__device__ __forceinline__ int seq_of_row(int r) { return r < NTOK_P ? 0 : 1 + ((r - NTOK_P) >> 6); }
__device__ __forceinline__ float rstd_of(const float* rsq) {
    const f32x4 a = *(const f32x4*)rsq, b = *(const f32x4*)(rsq + 4), c = *(const f32x4*)(rsq + 8), d = *(const f32x4*)(rsq + 12);
    const float s = ((a[0] + a[1]) + (a[2] + a[3])) + ((b[0] + b[1]) + (b[2] + b[3])) + ((c[0] + c[1]) + (c[2] + c[3])) + ((d[0] + d[1]) + (d[2] + d[3]));
    return 1.0f / sqrtf(s * (1.0f / D_MODEL) + NEPS);
}


struct EpiProj {
    static constexpr bool PERM = true, AFTER_DRAIN = false;
    bf16_t* proj; float* ra; const float* rowsq; const float* bias;
    __device__ __forceinline__ void operator()(const f32x4 (&acc)[2][2][4][2], const Unit& u, int wr, int wc, int fr, int fq) const {
#pragma unroll
        for (int ai = 0; ai < 2; ++ai) {
            const int rowb = u.pm * BM + ai * HALF + wr * 64; const int s = seq_of_row(rowb);
            const int colt = u.pn * BM + wc * 32 + 8 * fq;
            const float* bs = bias + (size_t)s * NIN_PAD + colt;
            f32x4 bv[2][2];
#pragma unroll
            for (int bj = 0; bj < 2; ++bj)
#pragma unroll
                for (int n = 0; n < 2; ++n) bv[bj][n] = *(const f32x4*)(bs + bj * HALF + 4 * n);
#pragma unroll
            for (int m = 0; m < 4; ++m) { const int r = rowb + m * 16 + fr; const float rs = rstd_of(rowsq + (size_t)r * 16);
#pragma unroll
                for (int bj = 0; bj < 2; ++bj) { const f32x4 v0 = acc[ai][bj][m][0] * rs + bv[bj][0], v1 = acc[ai][bj][m][1] * rs + bv[bj][1];
                    if (u.pn < 11) { u32x4 w; w.x = cvt_pk_bf16(v0[0], v0[1]); w.y = cvt_pk_bf16(v0[2], v0[3]); w.z = cvt_pk_bf16(v1[0], v1[1]); w.w = cvt_pk_bf16(v1[2], v1[3]);
                        *(u32x4*)(proj + (size_t)r * PLD + colt + bj * HALF) = w; }
                    else if (bj == 0 && wc == 0 && fq < 2) { *(f32x4*)(ra + (size_t)r * 16 + 8 * fq) = v0; *(f32x4*)(ra + (size_t)r * 16 + 8 * fq + 4) = v1; } } }
        }
    }
};
struct EpiUp {
    static constexpr bool PERM = true, AFTER_DRAIN = false;
    bf16_t* H; const float* rowsq; const float* bias;
    __device__ __forceinline__ void operator()(const f32x4 (&acc)[2][2][4][2], const Unit& u, int wr, int wc, int fr, int fq) const {
#pragma unroll
        for (int ai = 0; ai < 2; ++ai) {
            const int rowb = u.pm * BM + ai * HALF + wr * 64; const int s = seq_of_row(rowb);
            const int colt = u.pn * BM + wc * 32 + 8 * fq;
            const float* bs = bias + (size_t)s * DFF + colt;
            f32x4 bv[2][2];
#pragma unroll
            for (int bj = 0; bj < 2; ++bj)
#pragma unroll
                for (int n = 0; n < 2; ++n) bv[bj][n] = *(const f32x4*)(bs + bj * HALF + 4 * n);
#pragma unroll
            for (int m = 0; m < 4; ++m) { const int r = rowb + m * 16 + fr; const float rs = rstd_of(rowsq + (size_t)r * 16);
#pragma unroll
                for (int bj = 0; bj < 2; ++bj) { f32x4 v0 = acc[ai][bj][m][0] * rs + bv[bj][0], v1 = acc[ai][bj][m][1] * rs + bv[bj][1];
#pragma unroll
                    for (int e = 0; e < 4; ++e) { const float a = fmaxf(v0[e], 0.f), b = fmaxf(v1[e], 0.f); v0[e] = a * a; v1[e] = b * b; }
                    u32x4 w; w.x = cvt_pk_bf16(v0[0], v0[1]); w.y = cvt_pk_bf16(v0[2], v0[3]); w.z = cvt_pk_bf16(v1[0], v1[1]); w.w = cvt_pk_bf16(v1[2], v1[3]);
                    *(u32x4*)(H + (size_t)r * DFF + colt + bj * HALF) = w; } }
        }
    }
};
struct EpiRes {
    static constexpr bool PERM = false, AFTER_DRAIN = false;
    const float* basep; const float* bases; float* out; const float* gate;
    const float* gn; const float* scn; bf16_t* xn; float* rowsq;
    __device__ __forceinline__ void operator()(const f32x4 (&acc)[2][2][4][2], const Unit& u, int wr, int wc, int fr, int fq) const {
#pragma unroll
        for (int ai = 0; ai < 2; ++ai) {
            const int rowb = u.pm * BM + ai * HALF + wr * 64; const int s = seq_of_row(rowb);
            const int colt = u.pn * BM + wc * 32 + 4 * fq;
            f32x4 gv[2][2], wv[2][2];
#pragma unroll
            for (int bj = 0; bj < 2; ++bj)
#pragma unroll
                for (int n = 0; n < 2; ++n) { const int c = colt + bj * HALF + 16 * n; gv[bj][n] = *(const f32x4*)(gate + (size_t)s * NMOD + c);
                    if (gn) { const f32x4 g = *(const f32x4*)(gn + c), sc = *(const f32x4*)(scn + (size_t)s * NMOD + c); wv[bj][n] = g * (sc + 1.0f); } else wv[bj][n] = (f32x4){0.f, 0.f, 0.f, 0.f}; }
#pragma unroll
            for (int m = 0; m < 4; ++m) { const int r = rowb + m * 16 + fr;
                const float* bp = (r < NTOK_P) ? basep + (size_t)r * D_MODEL : bases + (size_t)(r - NTOK_P) * D_MODEL;
                float ss = 0.f;
#pragma unroll
                for (int bj = 0; bj < 2; ++bj)
#pragma unroll
                    for (int n = 0; n < 2; ++n) { const int c = colt + bj * HALF + 16 * n;
                        const f32x4 bsv = *(const f32x4*)(bp + c); const f32x4 x1 = bsv + gv[bj][n] * acc[ai][bj][m][n];
                        *(f32x4*)(out + (size_t)r * D_MODEL + c) = x1;
                        ss += (x1[0] * x1[0] + x1[1] * x1[1]) + (x1[2] * x1[2] + x1[3] * x1[3]);
                        if (gn) { const f32x4 y = x1 * wv[bj][n]; u32x2 w; w.x = cvt_pk_bf16(y[0], y[1]); w.y = cvt_pk_bf16(y[2], y[3]); *(u32x2*)(xn + (size_t)r * D_MODEL + c) = w; } }
                ss += __shfl_xor(ss, 16); ss += __shfl_xor(ss, 32);
                if (fq == 0) rowsq[(size_t)r * 16 + u.pn * 4 + wc] = ss;
            }
        }
    }
};
template <class Epi, class Sched, bool ALIGN_EPI = false, bool SP2 = false>
__device__ __forceinline__ void gemm_phase(PG8_LAS unsigned char* lds, const Gemm g, const Sched& S, const Epi& E) {
    const int tid = threadIdx.x, wid = __builtin_amdgcn_readfirstlane(tid >> 6), lane = tid & 63, wr = wid >> 2, wc = wid & 3, fr = lane & 15, fq = lane >> 4;
    const int K = g.K, nt = K / BK;
    unsigned voffA[2], voffB[2];
#pragma unroll
    for (int i = 0; i < 2; ++i) { int R, C; stage_rc(tid * 16 + i * 8192, R, C); const int Rb = Epi::PERM ? ((R & ~31) + perm32(R & 31)) : R;
        voffA[i] = (unsigned)(R * K + C) * 2u; voffB[i] = (unsigned)(Rb * K + C) * 2u; }
    const size_t kstep = (size_t)(BK * 2);
    const size_t hstep = (size_t)HALF * K * 2;
    const size_t tstep = 2 * hstep;
    const unsigned ldsw = (unsigned)wid * 1024u;
    const int aoff = lds_byte(wr * 64 + fr, fq * 8), boff = lds_byte(wc * 32 + fr, fq * 8);
#define PG8_SA(b, h) (((b) * 2 + (h)) * HTB)
#define PG8_SB(b, h) ((4 + (b) * 2 + (h)) * HTB)
#define PG8_STAGE(bufoff, gbase, voff) do { _Pragma("unroll") for (int _i = 0; _i < 2; ++_i) \
        __builtin_amdgcn_global_load_lds((const unsigned*)((const char*)(gbase) + (voff)[_i]), (PG8_LAS unsigned*)(lds + (bufoff) + ldsw + _i * 8192), 16, 0, 0); } while (0)
#define PG8_LDA(dst, b, h) do { _Pragma("unroll") for (int m = 0; m < 4; ++m) _Pragma("unroll") for (int k = 0; k < 2; ++k) dst[m][k] = *(const PG8_LAS bf16x8*)(lds + PG8_SA(b, h) + aoff + m * 2048 + k * 1024); } while (0)
#define PG8_LDB(dst, b, h) do { _Pragma("unroll") for (int n = 0; n < 2; ++n) _Pragma("unroll") for (int k = 0; k < 2; ++k) dst[n][k] = *(const PG8_LAS bf16x8*)(lds + PG8_SB(b, h) + boff + n * 2048 + k * 1024); } while (0)
#define PG8_MMA(ai, bj, At, Bt) do { __builtin_amdgcn_s_setprio(1); _Pragma("unroll") for (int m = 0; m < 4; ++m) _Pragma("unroll") for (int n = 0; n < 2; ++n) _Pragma("unroll") for (int k = 0; k < 2; ++k) \
        acc[ai][bj][m][n] = __builtin_amdgcn_mfma_f32_16x16x32_bf16(Bt[n][k], At[m][k], acc[ai][bj][m][n], 0, 0, 0); __builtin_amdgcn_s_setprio(0); } while (0)
#define PG8_WAIT_V(n) asm volatile("s_waitcnt vmcnt(" #n ")" ::: "memory")
#define PG8_WAIT_L(n) asm volatile("s_waitcnt lgkmcnt(" #n ")" ::: "memory")
#define PG8_BAR __builtin_amdgcn_s_barrier()
#define PG8_SCHED __builtin_amdgcn_sched_barrier(0)
    Unit cur, nxt; int ui = 0;
    if (!S.next(0, cur)) return;
    f32x4 acc[2][2][4][2];
#pragma unroll
    for (int a = 0; a < 2; ++a)
#pragma unroll
        for (int b = 0; b < 2; ++b)
#pragma unroll
            for (int m = 0; m < 4; ++m)
#pragma unroll
                for (int n = 0; n < 2; ++n) acc[a][b][m][n] = (f32x4){0.f, 0.f, 0.f, 0.f};
    bf16x8 At[4][2], B0[2][2], B1[2][2];
    const char* cA = (const char*)g.A + (size_t)cur.pm * tstep; const char* cB = (const char*)g.Bt + (size_t)cur.pn * tstep;
    S.a_ready(cur);
    if constexpr (SP2) {
        PG8_STAGE(PG8_SB(0, 0), cB, voffB); PG8_STAGE(PG8_SB(0, 1), cB + hstep, voffB); PG8_STAGE(PG8_SA(0, 0), cA, voffA); PG8_STAGE(PG8_SA(0, 1), cA + hstep, voffA);
        if (wr == 1) PG8_BAR;
        PG8_WAIT_V(2); PG8_BAR;
        PG8_STAGE(PG8_SB(1, 0), cB + kstep, voffB); PG8_STAGE(PG8_SA(1, 0), cA + kstep, voffA); PG8_STAGE(PG8_SB(1, 1), cB + hstep + kstep, voffB);
        PG8_WAIT_V(6); PG8_BAR;
    } else {
        PG8_STAGE(PG8_SB(0, 0), cB, voffB); PG8_STAGE(PG8_SA(0, 0), cA, voffA); PG8_STAGE(PG8_SB(0, 1), cB + hstep, voffB); PG8_STAGE(PG8_SA(0, 1), cA + hstep, voffA);
        if (wr == 1) PG8_BAR;
        PG8_WAIT_V(4); PG8_BAR;
        PG8_STAGE(PG8_SB(1, 0), cB + kstep, voffB); PG8_STAGE(PG8_SA(1, 0), cA + kstep, voffA); PG8_STAGE(PG8_SB(1, 1), cB + hstep + kstep, voffB);
        PG8_WAIT_V(6); PG8_BAR;
    }
    for (;;) {
        const bool has_next = S.next(ui + 1, nxt);
        const char* nA = has_next ? (const char*)g.A + (size_t)nxt.pm * tstep : cA; const char* nB = has_next ? (const char*)g.Bt + (size_t)nxt.pn * tstep : cB;
        for (int t = 0; t < nt; t += 2) {
            const bool last = (t == nt - 2);
            const char* a1 = cA + (size_t)(t + 1) * kstep;
            const char* a2 = last ? nA : cA + (size_t)(t + 2) * kstep; const char* b2 = last ? nB : cB + (size_t)(t + 2) * kstep;
            const char* a3 = a2 + kstep; const char* b3 = b2 + kstep;
            if (last && has_next) S.a_ready(nxt);
            if constexpr (SP2) {
            PG8_LDB(B0, 0, 0); PG8_LDB(B1, 0, 1); PG8_SCHED; PG8_LDA(At, 0, 0); PG8_STAGE(PG8_SA(1, 1), a1 + hstep, voffA);
            PG8_WAIT_V(8); PG8_WAIT_L(0); PG8_BAR; PG8_MMA(0, 0, At, B0); PG8_MMA(0, 1, At, B1); PG8_BAR; PG8_SCHED;
            PG8_LDA(At, 0, 1); PG8_STAGE(PG8_SB(0, 0), b2, voffB); PG8_STAGE(PG8_SB(0, 1), b2 + hstep, voffB); PG8_STAGE(PG8_SA(0, 0), a2, voffA);
            PG8_WAIT_V(8); PG8_WAIT_L(0); PG8_BAR; PG8_MMA(1, 0, At, B0); PG8_MMA(1, 1, At, B1); PG8_BAR; PG8_SCHED;
            PG8_LDB(B0, 1, 0); PG8_LDB(B1, 1, 1); PG8_SCHED; PG8_LDA(At, 1, 0); PG8_STAGE(PG8_SA(0, 1), a2 + hstep, voffA);
            PG8_WAIT_V(8); PG8_WAIT_L(0); PG8_BAR; PG8_MMA(0, 0, At, B0); PG8_MMA(0, 1, At, B1); PG8_BAR; PG8_SCHED;
            PG8_LDA(At, 1, 1); PG8_STAGE(PG8_SB(1, 0), b3, voffB); PG8_STAGE(PG8_SB(1, 1), b3 + hstep, voffB); PG8_STAGE(PG8_SA(1, 0), a3, voffA);
            PG8_WAIT_V(8); PG8_WAIT_L(0); PG8_BAR; PG8_MMA(1, 0, At, B0); PG8_MMA(1, 1, At, B1); PG8_BAR; PG8_SCHED;
            } else {
            PG8_LDB(B0, 0, 0); PG8_SCHED; PG8_LDA(At, 0, 0); PG8_STAGE(PG8_SA(1, 1), a1 + hstep, voffA);
            PG8_WAIT_L(8); PG8_BAR; PG8_WAIT_L(0); PG8_MMA(0, 0, At, B0); PG8_BAR; PG8_SCHED;
            PG8_LDB(B1, 0, 1); PG8_STAGE(PG8_SB(0, 0), b2, voffB);
            PG8_BAR; PG8_WAIT_L(0); PG8_MMA(0, 1, At, B1); PG8_BAR;
            PG8_LDA(At, 0, 1); PG8_STAGE(PG8_SA(0, 0), a2, voffA);
            PG8_BAR; PG8_WAIT_L(0); PG8_MMA(1, 0, At, B0); PG8_BAR; PG8_SCHED;
            PG8_STAGE(PG8_SB(0, 1), b2 + hstep, voffB);
            PG8_WAIT_V(6); PG8_BAR; PG8_MMA(1, 1, At, B1); PG8_BAR;
            PG8_LDB(B0, 1, 0); PG8_SCHED; PG8_LDA(At, 1, 0); PG8_STAGE(PG8_SA(0, 1), a2 + hstep, voffA);
            PG8_WAIT_L(8); PG8_BAR; PG8_WAIT_L(0); PG8_MMA(0, 0, At, B0); PG8_BAR; PG8_SCHED;
            PG8_LDB(B1, 1, 1); PG8_STAGE(PG8_SB(1, 0), b3, voffB);
            PG8_BAR; PG8_WAIT_L(0); PG8_MMA(0, 1, At, B1); PG8_BAR;
            PG8_LDA(At, 1, 1); PG8_STAGE(PG8_SA(1, 0), a3, voffA);
            PG8_BAR; PG8_WAIT_L(0); PG8_MMA(1, 0, At, B0); PG8_BAR; PG8_SCHED;
            PG8_STAGE(PG8_SB(1, 1), b3 + hstep, voffB);
            PG8_WAIT_V(6); PG8_BAR; PG8_MMA(1, 1, At, B1); PG8_BAR;
            }
        }
        if constexpr (ALIGN_EPI) { if (wr == 0) PG8_BAR; }
        if constexpr (!Epi::AFTER_DRAIN) { E(acc, cur, wr, wc, fr, fq); S.done(cur); }
        if (!has_next) break;
#pragma unroll
        for (int a = 0; a < 2; ++a)
#pragma unroll
            for (int b = 0; b < 2; ++b)
#pragma unroll
                for (int m = 0; m < 4; ++m)
#pragma unroll
                    for (int n = 0; n < 2; ++n) acc[a][b][m][n] = (f32x4){0.f, 0.f, 0.f, 0.f};
        cur = nxt; cA = nA; cB = nB; ++ui;
        if constexpr (ALIGN_EPI) { if (wr == 1) PG8_BAR; }
    }
    PG8_WAIT_V(0);
    if constexpr (!ALIGN_EPI) { if (wr == 0) PG8_BAR; }
    PG8_BAR;
    if constexpr (Epi::AFTER_DRAIN) { E.fused(acc, cur, wr, wc, fr, fq, lds, wid, lane); S.done(cur); }
#undef PG8_SA
#undef PG8_SB
#undef PG8_STAGE
#undef PG8_LDA
#undef PG8_LDB
#undef PG8_MMA
#undef PG8_WAIT_V
#undef PG8_WAIT_L
#undef PG8_BAR
#undef PG8_SCHED
}
}

constexpr int NWAVES = 8;
constexpr int DEPTH = 2, DM = 1024, NTP = 16384, NTS = 2048, MTOK = NTP + NTS, NSEQ = 33, NCHUNK = MTOK / 64;
constexpr int PLD = 2816, NINP = 3072, NIN_SRC = 2832, DFF = 4096, NMOD = 6144;
constexpr float EPS = 1e-6f;
constexpr int C_QA = 0, C_KA = 256, C_VA = 512, C_GA = 1024, C_QB = 1536, C_KB = 1792, C_VB = 1920, C_QC = 2048, C_KC = 2304, C_VC = 2560;
constexpr size_t O_Y = 0, O_SGP = 18874368, O_KBP = 18939904, O_VBP = 18972672, O_KCP = 19005440, O_VCP = 19267584, O_SGS = 19529728,
                 O_KBS = 21626880, O_VBS = 22675456, O_KCS = 23724032, O_VCS = 32112640, O_END = 40501248;
constexpr size_t MiB = 1u << 20;
constexpr size_t WS_CTL = 0, CTL_ZERO_BYTES = 1 * MiB;
constexpr size_t WS_MOD = 1 * MiB, WS_BIASM = 3 * MiB, WS_BIASF = 4 * MiB, WS_ROWSQ = 6 * MiB, WS_RA = 8 * MiB, WS_DN = 10 * MiB;
constexpr size_t WS_WIN = 12 * MiB, WS_WOUT = 24 * MiB, WS_WUP = 28 * MiB, WS_WDN = 44 * MiB;
constexpr size_t WS_XN = 60 * MiB;
constexpr size_t WS_PROJ = 96 * MiB;
constexpr size_t WS_MIXED = 195 * MiB;
constexpr size_t WS_SST = 231 * MiB;
constexpr size_t WS_H = 96 * MiB;
constexpr size_t WS_END = 249 * MiB;
constexpr int CW_TMO = 0, CW_CODE = 1, CW_BAR = 4096, CW_Q = 16384;
constexpr int RING_OFF = 0, RING_BYTES = 131072;
constexpr int LDSCTL_OFF = 160 * 1024 - 1024, MISC_OFF = LDSCTL_OFF + 320, TBL_OFF = LDSCTL_OFF + 512;
constexpr int LDS_BYTES = 160 * 1024;

#define GAS __attribute__((address_space(1)))
#define LAS __attribute__((address_space(3)))
typedef unsigned short bf16;
typedef unsigned v4u __attribute__((ext_vector_type(4)));
typedef unsigned v2u __attribute__((ext_vector_type(2)));
typedef float f32x4 __attribute__((ext_vector_type(4)));
typedef GAS unsigned gu32;
#define RLX_AGENT __ATOMIC_RELAXED, __HIP_MEMORY_SCOPE_AGENT
#define LDS_WAIT() asm volatile("s_waitcnt lgkmcnt(0)" ::: "memory")
#define VM_WAIT() asm volatile("s_waitcnt vmcnt(0)" ::: "memory")
__device__ __forceinline__ unsigned f2bf(float f) { unsigned u = __builtin_bit_cast(unsigned, f); return (u + 0x7fffu + ((u >> 16) & 1u)) >> 16; }
__device__ __forceinline__ unsigned pk2(float lo, float hi) { return f2bf(lo) | (f2bf(hi) << 16); }
__device__ __forceinline__ float bf2f(unsigned short h) { return __builtin_bit_cast(float, (unsigned)h << 16); }
__device__ __forceinline__ float bflo(unsigned w) { return __builtin_bit_cast(float, w << 16); }
__device__ __forceinline__ float bfhi(unsigned w) { return __builtin_bit_cast(float, w & 0xffff0000u); }
__device__ __forceinline__ float wave_sum(float v) {
#pragma unroll
    for (int o = 1; o < 64; o <<= 1) v += __shfl_xor(v, o);
    return v;
}
__device__ __forceinline__ float wave_max(float v) {
#pragma unroll
    for (int o = 1; o < 64; o <<= 1) v = fmaxf(v, __shfl_xor(v, o));
    return v;
}
__device__ __forceinline__ float silu_f(float x) { return x / (1.0f + __expf(-x)); }
__device__ __forceinline__ float logsigmoid_f(float x) { return fminf(x, 0.f) - log1pf(__expf(-fabsf(x))); }
#define XB_TMO      128
#define XB_XCNT(j)  (256  + 64 * (j))
#define XB_XSUB(j)  (1280 + 64 * (j))
#define XB_XGEN(j)  (2304 + 64 * (j))
#define XB_TOP      3328
#define XB_TOPGEN   3392
#define XCD_BAR_WORDS 3456
#define XB_SPIN_CAP (1u << 24)

__device__ __forceinline__ unsigned xb_ld(unsigned* p)              { return __hip_atomic_load(p, __ATOMIC_RELAXED, __HIP_MEMORY_SCOPE_AGENT); }
__device__ __forceinline__ unsigned xb_add(unsigned* p, unsigned v) { return __hip_atomic_fetch_add(p, v, __ATOMIC_RELAXED, __HIP_MEMORY_SCOPE_AGENT); }
__device__ __forceinline__ unsigned xb_xcc_id() { return (unsigned)__builtin_amdgcn_s_getreg((3 << 11) | 20) & 0xFu; }
#define XB_SPIN(cond, bar) do { unsigned _sp = 0; while (cond) { __builtin_amdgcn_s_sleep(1); \
    if ((++_sp & 255u) == 0u) { if (xb_ld(&(bar)[XB_TMO])) break; if (_sp > XB_SPIN_CAP) { atomicAdd(&(bar)[XB_TMO], 1u); break; } } } } while (0)

struct XcdBarrier {
    unsigned* bar; unsigned x;
    volatile LAS unsigned* st;
};

__device__ __forceinline__ XcdBarrier xcd_barrier_post(unsigned* bar, volatile LAS unsigned* st) {
    XcdBarrier b; b.bar = bar; b.x = xb_xcc_id(); b.st = st;
    if (threadIdx.x == 0) (void)xb_add(&bar[XB_XCNT(b.x)], 1u);
    return b;
}
__device__ __forceinline__ void xcd_barrier_complete(unsigned* bar, unsigned x, unsigned& nloc, unsigned& nx) {
    const unsigned G = gridDim.x * gridDim.y * gridDim.z;
    unsigned sum, cnt, mine, sp = 0u;
    for (;;) {
        sum = 0u; cnt = 0u; mine = 0u;
#pragma unroll
        for (unsigned j = 0; j < 16; ++j) { const unsigned c = xb_ld(&bar[XB_XCNT(j)]); sum += c; cnt += (c > 0u) ? 1u : 0u; mine = (j == x) ? c : mine; }
        if (sum == G) break;
        __builtin_amdgcn_s_sleep(1);
        if ((++sp & 255u) == 0u) { if (xb_ld(&bar[XB_TMO])) break; if (sp > XB_SPIN_CAP) { atomicAdd(&bar[XB_TMO], 1u); break; } }
    }
    nloc = mine > 0u ? mine : 1u; nx = cnt > 0u ? cnt : 1u;
}

__device__ __forceinline__ void xcd_barrier(const XcdBarrier& b) {
    asm volatile("s_waitcnt vmcnt(0)" ::: "memory");
    __syncthreads();
    if (threadIdx.x == 0) {
        unsigned* bar = b.bar;
        __builtin_amdgcn_s_waitcnt(0);
        unsigned nloc = b.st[0], nx = b.st[1];
        if (nloc == 0u) { xcd_barrier_complete(bar, b.x, nloc, nx); b.st[0] = nloc; b.st[1] = nx; }
        const unsigned old = xb_add(&bar[XB_XSUB(b.x)], 1u);
        const unsigned gen = old / nloc;
        if (old + 1u == (gen + 1u) * nloc) {
            __builtin_amdgcn_fence(__ATOMIC_RELEASE, "agent");
            asm volatile("s_waitcnt vmcnt(0)" ::: "memory");
            const unsigned og = xb_add(&bar[XB_TOP], 1u);
            const unsigned tg = og / nx;
            if (og + 1u == (tg + 1u) * nx) xb_add(&bar[XB_TOPGEN], 1u);
            else XB_SPIN(xb_ld(&bar[XB_TOPGEN]) == tg, bar);
            __builtin_amdgcn_fence(__ATOMIC_ACQUIRE, "agent");
            xb_add(&bar[XB_XGEN(b.x)], 1u);
            asm volatile("s_waitcnt vmcnt(0)" ::: "memory");
        } else {
            XB_SPIN(xb_ld(&bar[XB_XGEN(b.x)]) == gen, bar);
            __builtin_amdgcn_fence(__ATOMIC_ACQUIRE, "agent");
            asm volatile("s_waitcnt vmcnt(0)" ::: "memory");
        }
    }
    __syncthreads();
}

struct Args { const float* in[24]; float* out; unsigned char* ws; int ph_lo, ph_hi; };
static_assert(sizeof(Args) == 24 * 8 + 8 + 8 + 8, "Args has no padding");
__device__ __forceinline__ const float* inp_ptr(LAS unsigned char* lds, int i) {
    const unsigned long long v = ((const volatile LAS unsigned long long*)(lds + TBL_OFF))[i];
    const unsigned lo = __builtin_amdgcn_readfirstlane((unsigned)v), hi = __builtin_amdgcn_readfirstlane((unsigned)(v >> 32));
    return (const float*)(((unsigned long long)hi << 32) | lo);
}
#define INP(i) inp_ptr(F.lds, (i))
struct Frame {
    LAS unsigned char* lds;
    volatile LAS unsigned* MISC;
    gu32* ctl;
    int tid, lane, wave, vcu, G;
    float* out; unsigned char* ws;
};
#define IN_XP 0
#define IN_XS 1
#define IN_CP 2
#define IN_CS 3
#define IN_SG 4
#define IN_CBK 5
#define IN_CBV 6
#define IN_CCK 7
#define IN_CCV 8
#define IN_WADA 9
#define IN_BADA 10
#define IN_GMIX 11
#define IN_GMLP 12
#define IN_WIN 13
#define IN_WA2 14
#define IN_BA2 15
#define IN_ANG 16
#define IN_SINK 17
#define IN_T5 18
#define IN_CREL 19
#define IN_WOUT 20
#define IN_WUP 21
#define IN_WDN 22
#define IN_GFIN 23

__device__ __forceinline__ int win_colmap(int n) { return n < 1536 ? n : (n < 2816 ? n + 16 : (n < 2832 ? n - 2816 + 1536 : -1)); }
template <bool WINMAP>
__device__ __forceinline__ void p0_transpose_item(const float* W, int K, int Nsrc, int Npad, bf16* WT, LAS float* scr, int item, int lane) {
    const int nblk = Npad / 32, kb = item / nblk, nb = item % nblk, k0 = 64 * kb, n0 = 32 * nb;
    const int nn = n0 + (lane & 31); const int sc = WINMAP ? win_colmap(nn) : nn;
#pragma unroll 8
    for (int i = 0; i < 32; ++i) { const int kk = 2 * i + (lane >> 5); scr[kk * 33 + (lane & 31)] = (sc >= 0) ? W[(size_t)(k0 + kk) * Nsrc + sc] : 0.f; }
    LDS_WAIT(); asm volatile("" ::: "memory");
    const int c = lane & 7;
#pragma unroll
    for (int j = 0; j < 4; ++j) { const int n = (lane >> 3) + 8 * j; const LAS float* s = scr + (8 * c) * 33 + n;
        v4u o; o.x = pk2(s[0 * 33], s[1 * 33]); o.y = pk2(s[2 * 33], s[3 * 33]); o.z = pk2(s[4 * 33], s[5 * 33]); o.w = pk2(s[6 * 33], s[7 * 33]);
        *(GAS v4u*)(WT + (size_t)(n0 + n) * K + k0 + 8 * c) = o; }
    LDS_WAIT(); asm volatile("" ::: "memory");
}
__device__ __forceinline__ void p0_transposes(Frame& F) {
    LAS float* scr = (LAS float*)(F.lds + RING_OFF + F.wave * 16384);
    const int gw = F.vcu * NWAVES + F.wave, NGW = F.G * NWAVES;
    constexpr int I_IN = 16 * 96, I_OUT = 16 * 32, I_UP = 16 * 128, I_DN = 64 * 32, I_L = I_IN + I_OUT + I_UP + I_DN;
    for (int it = gw; it < DEPTH * I_L; it += NGW) {
        const int l = it / I_L; int r = it % I_L;
        if (r < I_IN) { p0_transpose_item<true>(INP(IN_WIN) + (size_t)l * DM * NIN_SRC, DM, NIN_SRC, NINP, (bf16*)(F.ws + WS_WIN) + (size_t)l * NINP * DM, scr, r, F.lane); continue; } r -= I_IN;
        if (r < I_OUT) { p0_transpose_item<false>(INP(IN_WOUT) + (size_t)l * DM * DM, DM, DM, DM, (bf16*)(F.ws + WS_WOUT) + (size_t)l * DM * DM, scr, r, F.lane); continue; } r -= I_OUT;
        if (r < I_UP) { p0_transpose_item<false>(INP(IN_WUP) + (size_t)l * DM * DFF, DM, DFF, DFF, (bf16*)(F.ws + WS_WUP) + (size_t)l * DFF * DM, scr, r, F.lane); continue; } r -= I_UP;
        p0_transpose_item<false>(INP(IN_WDN) + (size_t)l * DFF * DM, DFF, DM, DM, (bf16*)(F.ws + WS_WDN) + (size_t)l * DM * DFF, scr, r, F.lane);
    }
}
template <int MODE>
__device__ __forceinline__ void skinny_item(Frame& F, int l, int item) {
    LAS float* A = (LAS float*)(F.lds);
    LAS float* RED = (LAS float*)(F.lds + 73728);
    const int n0 = item * 64, col = n0 + F.lane;
    const float* W; int ldw, scol; float* out; int ldo; float addb = 0.f;
    float* MOD = (float*)(F.ws + WS_MOD) + (size_t)l * NSEQ * NMOD;
    if (MODE == 0) { W = INP(IN_WADA) + (size_t)l * DM * NMOD; ldw = NMOD; scol = col; out = MOD; ldo = NMOD; }
    else if (MODE == 1) { W = INP(IN_WIN) + (size_t)l * DM * NIN_SRC; ldw = NIN_SRC; scol = win_colmap(col); out = (float*)(F.ws + WS_BIASM) + (size_t)l * NSEQ * NINP; ldo = NINP; }
    else { W = INP(IN_WUP) + (size_t)l * DM * DFF; ldw = DFF; scol = col; out = (float*)(F.ws + WS_BIASF) + (size_t)l * NSEQ * DFF; ldo = DFF; }
    float acc[36];
#pragma unroll
    for (int s = 0; s < 36; ++s) acc[s] = 0.f;
    for (int kh = 0; kh < 2; ++kh) {
        __syncthreads();
        { const int kk = F.tid, k = 512 * kh + kk;
#pragma unroll 1
          for (int s = 0; s < NSEQ; ++s) { float a;
              if (MODE == 0) { const float c = (s == 0) ? INP(IN_CP)[k] : INP(IN_CS)[(size_t)(s - 1) * DM + k]; a = silu_f(c); }
              else a = MOD[(size_t)s * NMOD + (MODE == 1 ? 0 : 3072) + k];
              A[kk * 36 + s] = a; }
          A[kk * 36 + 33] = 0.f; A[kk * 36 + 34] = 0.f; A[kk * 36 + 35] = 0.f; }
        __syncthreads();
        const int kb = F.wave * 64;
#pragma unroll 4
        for (int kk = kb; kk < kb + 64; ++kk) {
            const float wv = (scol >= 0) ? W[(size_t)(512 * kh + kk) * ldw + scol] : 0.f;
#pragma unroll
            for (int s4 = 0; s4 < 9; ++s4) { const f32x4 a4 = *(const LAS f32x4*)(A + kk * 36 + 4 * s4);
                acc[4 * s4 + 0] += a4[0] * wv; acc[4 * s4 + 1] += a4[1] * wv; acc[4 * s4 + 2] += a4[2] * wv; acc[4 * s4 + 3] += a4[3] * wv; }
        }
    }
#pragma unroll
    for (int s = 0; s < NSEQ; ++s) RED[(F.wave * NSEQ + s) * 64 + F.lane] = acc[s];
    __syncthreads();
    for (int idx = F.tid; idx < NSEQ * 64; idx += NWAVES * 64) { const int s = idx >> 6, ln = idx & 63; float sum = 0.f;
#pragma unroll
        for (int w = 0; w < NWAVES; ++w) sum += RED[(w * NSEQ + s) * 64 + ln];
        if (MODE == 0) sum += INP(IN_BADA)[(size_t)l * NMOD + n0 + ln];
        out[(size_t)s * ldo + n0 + ln] = sum; }
    __syncthreads();
}
__device__ __forceinline__ void xn0_row(Frame& F, int m) {
    const float* xrow = (m < NTP) ? INP(IN_XP) + (size_t)m * DM : INP(IN_XS) + (size_t)(m - NTP) * DM;
    const int s = m < NTP ? 0 : 1 + ((m - NTP) >> 6);
    const float* sc = (const float*)(F.ws + WS_MOD) + (size_t)s * NMOD + 1024; const float* g = INP(IN_GMIX);
    bf16* orow = (bf16*)(F.ws + WS_XN) + (size_t)m * DM;
    float ss = 0.f;
#pragma unroll
    for (int j = 0; j < 4; ++j) { const int c = 4 * (F.lane + 64 * j); const f32x4 v = *(const f32x4*)(xrow + c), gg = *(const f32x4*)(g + c), s4 = *(const f32x4*)(sc + c);
        ss += (v[0] * v[0] + v[1] * v[1]) + (v[2] * v[2] + v[3] * v[3]);
        const f32x4 y = v * (gg * (s4 + 1.0f)); v2u w; w.x = pk2(y[0], y[1]); w.y = pk2(y[2], y[3]); *(v2u*)(orow + c) = w; }
    ss = wave_sum(ss);
    if (F.lane < 16) ((float*)(F.ws + WS_ROWSQ))[(size_t)m * 16 + F.lane] = (F.lane == 0) ? ss : 0.f;
}
__device__ __forceinline__ void final_row(Frame& F, int m) {
    float* xrow = F.out + (size_t)m * DM; const float* g = INP(IN_GFIN);
    const float rs = pg8::rstd_of((const float*)(F.ws + WS_ROWSQ) + (size_t)m * 16);
#pragma unroll
    for (int j = 0; j < 4; ++j) { const int c = 4 * (F.lane + 64 * j); const f32x4 v = *(const f32x4*)(xrow + c), gg = *(const f32x4*)(g + c); *(f32x4*)(xrow + c) = v * rs * gg; }
}

__device__ __forceinline__ int t5_bucket_dev(int rel) {
    const int n = rel < 0 ? -rel : rel; int b;
    if (n < 8) b = n; else { const int lg = 31 - __clz(n * n); int large = 2 + lg; if (large > 15) large = 15; b = large; }
    return (rel > 0 ? 16 : 0) + b;
}
template <int MIX>
__device__ __forceinline__ void attn_simple(Frame& F, int l) {
    constexpr int T0 = MIX ? 8 : 2, NT = T0 + 1, LC = 64 * T0, NKV = MIX ? 4 : 2;
    constexpr int QC = MIX ? C_QC : C_QB, KC = MIX ? C_KC : C_KB, VC = MIX ? C_VC : C_VB, OC = MIX ? 768 : 512;
    const bf16* proj = (const bf16*)(F.ws + WS_PROJ); bf16* mixed = (bf16*)(F.ws + WS_MIXED);
    const float* ck = (MIX ? INP(IN_CCK) : INP(IN_CBK)) + (size_t)l * 32 * LC * NKV * 64; const float* cv = (MIX ? INP(IN_CCV) : INP(IN_CBV)) + (size_t)l * 32 * LC * NKV * 64;
    const float* t5 = INP(IN_T5); const float* crel = INP(IN_CREL) + (size_t)l * 513 * 4; const float* sinkp = INP(IN_SINK) + l * 4;
    const int gw = F.vcu * NWAVES + F.wave, NGW = F.G * NWAVES, lane = F.lane;
    for (int task = gw; task < MTOK * 4; task += NGW) {
        const int m = task >> 2, h = task & 3, kvh = MIX ? h : (h >> 1);
        const bool isp = m < NTP; const int q = m & 63; const int n = m >> 6; const int b = (m - NTP) >> 6;
        const float qd = bf2f(proj[(size_t)m * PLD + QC + 64 * h + lane]);
        LAS float* scl = (LAS float*)(F.lds) + F.wave * 640;
        float mx = -1e30f;
#pragma unroll 1
        for (int i = 0; i < NT; ++i) {
            const int j = lane + 64 * i; float dot = 0.f; bool valid = true;
            if (isp || i == T0) {
                const long tok = isp ? (long)64 * (n - T0) + j : (long)NTP + 64 * b + (j - LC);
                valid = tok >= 0;
                const v4u* kp = (const v4u*)(proj + (size_t)(valid ? tok : 0) * PLD + KC + 64 * kvh);
#pragma unroll 2
                for (int c = 0; c < 8; ++c) { const v4u kv = kp[c];
                    const unsigned w[4] = {kv.x, kv.y, kv.z, kv.w};
#pragma unroll
                    for (int e = 0; e < 4; ++e) { dot += __shfl(qd, 8 * c + 2 * e) * bflo(w[e]); dot += __shfl(qd, 8 * c + 2 * e + 1) * bfhi(w[e]); } }
            } else {
                const f32x4* kp = (const f32x4*)(ck + (((size_t)b * LC + j) * NKV + kvh) * 64);
#pragma unroll 2
                for (int c = 0; c < 16; ++c) { const f32x4 kv = kp[c];
#pragma unroll
                    for (int e = 0; e < 4; ++e) dot += __shfl(qd, 4 * c + e) * kv[e]; }
            }
            const int rel = j - LC - q; float bias;
            if (MIX) { int rc = rel < -256 ? -256 : (rel > 256 ? 256 : rel); bias = crel[(rc + 256) * 4 + h]; }
            else bias = t5[t5_bucket_dev(rel) * 4 + h];
            const float sv = valid ? dot * 0.125f + bias : -1e30f;
            scl[j] = sv; mx = fmaxf(mx, sv);
        }
        mx = wave_max(mx);
        float sk = 0.f; if (!MIX) { sk = sinkp[h]; mx = fmaxf(mx, sk); }
        float sum = 0.f;
#pragma unroll 1
        for (int i = 0; i < NT; ++i) { const float p = __expf(scl[lane + 64 * i] - mx); scl[lane + 64 * i] = p; sum += p; }
        sum = wave_sum(sum); if (!MIX) sum += __expf(sk - mx);
        const float inv = 1.0f / sum;
        LDS_WAIT();
        float o = 0.f;
#pragma unroll 1
        for (int i = 0; i < NT; ++i) {
            if (isp || i == T0) {
                const long tok0 = isp ? (long)64 * (n - T0 + i) : (long)NTP + 64 * b;
                if (tok0 >= 0) {
                    const bf16* vp = proj + (size_t)tok0 * PLD + VC + 64 * kvh + lane;
#pragma unroll 8
                    for (int jj = 0; jj < 64; ++jj) o += scl[64 * i + jj] * bf2f(vp[(size_t)jj * PLD]);
                }
            } else {
                const float* vp = cv + (((size_t)b * LC + 64 * i) * NKV + kvh) * 64 + lane;
#pragma unroll 8
                for (int jj = 0; jj < 64; ++jj) o += scl[64 * i + jj] * vp[(size_t)jj * NKV * 64];
            }
        }
        LDS_WAIT();
        mixed[(size_t)m * DM + OC + 64 * h + lane] = (bf16)f2bf(o * inv);
    }
}
__device__ __forceinline__ void cache_out_simple(Frame& F, int l) {
    const bf16* proj = (const bf16*)(F.ws + WS_PROJ);
    const size_t gt = (size_t)F.vcu * NWAVES * 64 + F.tid, NGT = (size_t)F.G * NWAVES * 64;
    for (size_t i = gt; i < 2 * 16384; i += NGT) { const int kv = (int)(i / 16384), e = (int)(i % 16384), row = e / 128, c = e % 128;
        F.out[(kv ? O_VBP : O_KBP) + (size_t)l * 16384 + e] = bf2f(proj[(size_t)(NTP - 128 + row) * PLD + (kv ? C_VB : C_KB) + c]); }
    for (size_t i = gt; i < 2 * 131072; i += NGT) { const int kv = (int)(i / 131072), e = (int)(i % 131072), row = e / 256, c = e % 256;
        F.out[(kv ? O_VCP : O_KCP) + (size_t)l * 131072 + e] = bf2f(proj[(size_t)(NTP - 512 + row) * PLD + (kv ? C_VC : C_KC) + c]); }
    for (size_t i = gt; i < 2 * 524288; i += NGT) { const int kv = (int)(i / 524288), e = (int)(i % 524288), b = e / 16384, row = (e % 16384) / 128, c = e % 128;
        float v;
        if (row < 64) v = (kv ? INP(IN_CBV) : INP(IN_CBK))[(size_t)l * 524288 + (size_t)b * 16384 + (size_t)(row + 64) * 128 + c];
        else v = bf2f(proj[(size_t)(NTP + 64 * b + row - 64) * PLD + (kv ? C_VB : C_KB) + c]);
        F.out[(kv ? O_VBS : O_KBS) + (size_t)l * 524288 + e] = v; }
    for (size_t i = gt; i < 2 * 4194304; i += NGT) { const int kv = (int)(i / 4194304), e = (int)(i % 4194304), b = e / 131072, row = (e % 131072) / 256, c = e % 256;
        float v;
        if (row < 448) v = (kv ? INP(IN_CCV) : INP(IN_CCK))[(size_t)l * 4194304 + (size_t)b * 131072 + (size_t)(row + 64) * 256 + c];
        else v = bf2f(proj[(size_t)(NTP + 64 * b + row - 448) * PLD + (kv ? C_VC : C_KC) + c]);
        F.out[(kv ? O_VCS : O_KCS) + (size_t)l * 4194304 + e] = v; }
}
__device__ __forceinline__ void gla_simple(Frame& F, int l) {
    const bf16* proj = (const bf16*)(F.ws + WS_PROJ); const float* RA = (const float*)(F.ws + WS_RA); float* OG = (float*)(F.ws + WS_XN);
    const int gw = F.vcu * NWAVES + F.wave, NGW = F.G * NWAVES, lane = F.lane;
    for (int task = gw; task < NSEQ * 512; task += NGW) {
        const int s = task / 512, h = (task % 512) / 128, dv = task % 128;
        const int row0 = s == 0 ? 0 : NTP + 64 * (s - 1), nrow = s == 0 ? NTP : 64;
        float S = s == 0 ? 0.f : INP(IN_SG)[((((size_t)l * 32 + (s - 1)) * 4 + h) * 64 + lane) * 128 + dv];
        float wc[16];
#pragma unroll
        for (int r = 0; r < 16; ++r) wc[r] = INP(IN_WA2)[((size_t)l * 16 + r) * 256 + h * 64 + lane];
        const float ba = INP(IN_BA2)[(size_t)l * 256 + h * 64 + lane];
#pragma unroll 4
        for (int t = 0; t < nrow; ++t) {
            const int m = row0 + t; const float* ra = RA + (size_t)m * 16;
            float x = ba;
#pragma unroll
            for (int r = 0; r < 16; ++r) x += ra[r] * wc[r];
            const float alpha = __expf(logsigmoid_f(x) * (1.0f / 16.0f));
            const float qv = bf2f(proj[(size_t)m * PLD + C_QA + 64 * h + lane]) * 0.125f, kv = bf2f(proj[(size_t)m * PLD + C_KA + 64 * h + lane]);
            const float vv = bf2f(proj[(size_t)m * PLD + C_VA + 128 * h + dv]);
            S = alpha * S + kv * vv;
            const float o = wave_sum(qv * S);
            if (lane == 0) OG[(size_t)m * 512 + h * 128 + dv] = o;
        }
        float* so = F.out + (s == 0 ? O_SGP + (size_t)l * 32768 : O_SGS + ((size_t)l * 32 + (s - 1)) * 32768);
        so[((size_t)h * 64 + lane) * 128 + dv] = S;
    }
}
__device__ __forceinline__ void gla_norm_simple(Frame& F, int l) {
    const bf16* proj = (const bf16*)(F.ws + WS_PROJ); const float* OG = (const float*)(F.ws + WS_XN); bf16* mixed = (bf16*)(F.ws + WS_MIXED);
    const float* ng = INP(IN_ANG) + l * 128;
    const int gw = F.vcu * NWAVES + F.wave, NGW = F.G * NWAVES, lane = F.lane;
    for (int task = gw; task < MTOK * 4; task += NGW) {
        const int m = task >> 2, h = task & 3;
        const float o0 = OG[(size_t)m * 512 + h * 128 + lane], o1 = OG[(size_t)m * 512 + h * 128 + 64 + lane];
        const float ss = wave_sum(o0 * o0 + o1 * o1); const float rs = 1.0f / sqrtf(ss * (1.0f / 128.0f) + EPS);
        const float g0 = bf2f(proj[(size_t)m * PLD + C_GA + 128 * h + lane]), g1 = bf2f(proj[(size_t)m * PLD + C_GA + 128 * h + 64 + lane]);
        mixed[(size_t)m * DM + h * 128 + lane] = (bf16)f2bf(o0 * rs * ng[lane] * silu_f(g0));
        mixed[(size_t)m * DM + h * 128 + 64 + lane] = (bf16)f2bf(o1 * rs * ng[64 + lane] * silu_f(g1));
    }
}

#ifndef PHMASK
#define PHMASK 1023
#endif
#ifndef MK_ONE_LAUNCH
#define MK_ONE_LAUNCH 1
#endif
constexpr int PH_P0 = 0, PH_P1 = 1, PH_L0 = 2, PH_PER_LAYER = 7, PH_FINAL = PH_L0 + DEPTH * PH_PER_LAYER, N_PHASES = PH_FINAL + 1;

__global__ void __launch_bounds__(NWAVES * 64, 2) enc_fwd(Args args) {
    extern __shared__ __attribute__((aligned(16))) unsigned char lds[];
    Frame F;
    F.lds = (LAS unsigned char*)lds;
    F.MISC = (volatile LAS unsigned*)(F.lds + MISC_OFF);
    F.tid = threadIdx.x; F.lane = F.tid & 63; F.wave = __builtin_amdgcn_readfirstlane(F.tid >> 6);
    F.G = gridDim.x; { const int bx = blockIdx.x; F.vcu = (F.G % 8 == 0) ? (bx % 8) * (F.G / 8) + bx / 8 : bx; }
    F.out = args.out; F.ws = args.ws; F.ctl = (gu32*)(args.ws + WS_CTL);
    for (int u = F.tid; u < (LDS_BYTES - LDSCTL_OFF) / 4; u += NWAVES * 64) ((LAS unsigned*)(F.lds + LDSCTL_OFF))[u] = 0u;
    __syncthreads();
    if (F.tid == 0) { LAS unsigned long long* t = (LAS unsigned long long*)(F.lds + TBL_OFF);
#pragma unroll
        for (int i = 0; i < 24; ++i) t[i] = (unsigned long long)args.in[i]; }
    __syncthreads();
#if MK_ONE_LAUNCH
    XcdBarrier bar = xcd_barrier_post((unsigned*)(F.ctl + CW_BAR), F.MISC + 8);
#define GRID_BAR() xcd_barrier(bar)
#else
#define GRID_BAR() do {} while (0)
#endif
    const int lo = args.ph_lo, hi = args.ph_hi;
#define IN(k) (lo <= (k) && (k) < hi)
#define SEAM(k) do { if (IN(k) && IN((k) + 1)) GRID_BAR(); } while (0)
    const int gw = F.vcu * NWAVES + F.wave, NGW = F.G * NWAVES;

    if (IN(PH_P0) && (PHMASK & 1)) {
        for (int it = blockIdx.x; it < DEPTH * (NMOD / 64); it += F.G) skinny_item<0>(F, it / (NMOD / 64), it % (NMOD / 64));
        p0_transposes(F);
    }
    SEAM(PH_P0);
    if (IN(PH_P1) && (PHMASK & 2)) {
        constexpr int NB1 = NINP / 64, NB2 = DFF / 64;
        for (int it = blockIdx.x; it < DEPTH * (NB1 + NB2); it += F.G) { const int l = it / (NB1 + NB2), r = it % (NB1 + NB2);
            if (r < NB1) skinny_item<1>(F, l, r); else skinny_item<2>(F, l, r - NB1); }
        for (int m = gw; m < MTOK; m += NGW) xn0_row(F, m);
    }
    SEAM(PH_P1);
    float* MOD = (float*)(F.ws + WS_MOD);
    { constexpr int l = 0;
        const int pb = PH_L0 + l * PH_PER_LAYER;
        float* modl = MOD + (size_t)l * NSEQ * NMOD;
        if (IN(pb + 0) && (PHMASK & 4)) {
            pg8::Gemm g{(const bf16*)(F.ws + WS_XN), (const bf16*)(F.ws + WS_WIN) + (size_t)l * NINP * DM, MTOK, NINP, DM}; pg8::StaticOrder S; S.init(MTOK, NINP, F.G, (int)blockIdx.x);
            pg8::EpiProj E{(bf16*)(F.ws + WS_PROJ), (float*)(F.ws + WS_RA), (const float*)(F.ws + WS_ROWSQ), (const float*)(F.ws + WS_BIASM) + (size_t)l * NSEQ * NINP};
            pg8::gemm_phase<pg8::EpiProj, pg8::StaticOrder, true, true>(F.lds + RING_OFF, g, S, E);
        }
        SEAM(pb + 0);
        if (IN(pb + 1) && (PHMASK & 8)) { attn_simple<1>(F, l); attn_simple<0>(F, l); cache_out_simple(F, l); }
        SEAM(pb + 1);
        if (IN(pb + 2) && (PHMASK & 16)) { gla_simple(F, l); }
        SEAM(pb + 2);
        if (IN(pb + 3) && (PHMASK & 32)) { gla_norm_simple(F, l); }
        SEAM(pb + 3);
        if (IN(pb + 4) && (PHMASK & 64)) {
            pg8::Gemm g{(const bf16*)(F.ws + WS_MIXED), (const bf16*)(F.ws + WS_WOUT) + (size_t)l * DM * DM, MTOK, DM, DM}; pg8::StaticOrder S; S.init(MTOK, DM, F.G, (int)blockIdx.x);
            pg8::EpiRes E{l == 0 ? INP(IN_XP) : F.out, l == 0 ? INP(IN_XS) : F.out + (size_t)NTP * DM, F.out, modl + 2048,
                          INP(IN_GMLP) + (size_t)l * DM, modl + 4096, (bf16*)(F.ws + WS_XN), (float*)(F.ws + WS_ROWSQ)};
            pg8::gemm_phase<pg8::EpiRes, pg8::StaticOrder, true, true>(F.lds + RING_OFF, g, S, E);
        }
        SEAM(pb + 4);
        if (IN(pb + 5) && (PHMASK & 128)) {
            pg8::Gemm g{(const bf16*)(F.ws + WS_XN), (const bf16*)(F.ws + WS_WUP) + (size_t)l * DFF * DM, MTOK, DFF, DM}; pg8::StaticOrder S; S.init(MTOK, DFF, F.G, (int)blockIdx.x);
            pg8::EpiUp E{(bf16*)(F.ws + WS_H), (const float*)(F.ws + WS_ROWSQ), (const float*)(F.ws + WS_BIASF) + (size_t)l * NSEQ * DFF};
            pg8::gemm_phase<pg8::EpiUp, pg8::StaticOrder, true, true>(F.lds + RING_OFF, g, S, E);
        }
        SEAM(pb + 5);
        if (IN(pb + 6) && (PHMASK & 256)) {
            pg8::Gemm g{(const bf16*)(F.ws + WS_H), (const bf16*)(F.ws + WS_WDN) + (size_t)l * DM * DFF, MTOK, DM, DFF}; pg8::StaticOrder S; S.init(MTOK, DM, F.G, (int)blockIdx.x);
            const bool more = (l + 1 < DEPTH);
            pg8::EpiRes E{F.out, F.out + (size_t)NTP * DM, F.out, modl + 5120,
                          more ? INP(IN_GMIX) + (size_t)(l + 1) * DM : nullptr, MOD + (size_t)(l + 1 < DEPTH ? l + 1 : l) * NSEQ * NMOD + 1024, (bf16*)(F.ws + WS_XN), (float*)(F.ws + WS_ROWSQ)};
            pg8::gemm_phase<pg8::EpiRes, pg8::StaticOrder, true, true>(F.lds + RING_OFF, g, S, E);
        }
        SEAM(pb + 6);
        }
    { constexpr int l = 1;
        const int pb = PH_L0 + l * PH_PER_LAYER;
        float* modl = MOD + (size_t)l * NSEQ * NMOD;
        if (IN(pb + 0) && (PHMASK & 4)) {
            pg8::Gemm g{(const bf16*)(F.ws + WS_XN), (const bf16*)(F.ws + WS_WIN) + (size_t)l * NINP * DM, MTOK, NINP, DM}; pg8::StaticOrder S; S.init(MTOK, NINP, F.G, (int)blockIdx.x);
            pg8::EpiProj E{(bf16*)(F.ws + WS_PROJ), (float*)(F.ws + WS_RA), (const float*)(F.ws + WS_ROWSQ), (const float*)(F.ws + WS_BIASM) + (size_t)l * NSEQ * NINP};
            pg8::gemm_phase<pg8::EpiProj, pg8::StaticOrder, true, true>(F.lds + RING_OFF, g, S, E);
        }
        SEAM(pb + 0);
        if (IN(pb + 1) && (PHMASK & 8)) { attn_simple<1>(F, l); attn_simple<0>(F, l); cache_out_simple(F, l); }
        SEAM(pb + 1);
        if (IN(pb + 2) && (PHMASK & 16)) { gla_simple(F, l); }
        SEAM(pb + 2);
        if (IN(pb + 3) && (PHMASK & 32)) { gla_norm_simple(F, l); }
        SEAM(pb + 3);
        if (IN(pb + 4) && (PHMASK & 64)) {
            pg8::Gemm g{(const bf16*)(F.ws + WS_MIXED), (const bf16*)(F.ws + WS_WOUT) + (size_t)l * DM * DM, MTOK, DM, DM}; pg8::StaticOrder S; S.init(MTOK, DM, F.G, (int)blockIdx.x);
            pg8::EpiRes E{l == 0 ? INP(IN_XP) : F.out, l == 0 ? INP(IN_XS) : F.out + (size_t)NTP * DM, F.out, modl + 2048,
                          INP(IN_GMLP) + (size_t)l * DM, modl + 4096, (bf16*)(F.ws + WS_XN), (float*)(F.ws + WS_ROWSQ)};
            pg8::gemm_phase<pg8::EpiRes, pg8::StaticOrder, true, true>(F.lds + RING_OFF, g, S, E);
        }
        SEAM(pb + 4);
        if (IN(pb + 5) && (PHMASK & 128)) {
            pg8::Gemm g{(const bf16*)(F.ws + WS_XN), (const bf16*)(F.ws + WS_WUP) + (size_t)l * DFF * DM, MTOK, DFF, DM}; pg8::StaticOrder S; S.init(MTOK, DFF, F.G, (int)blockIdx.x);
            pg8::EpiUp E{(bf16*)(F.ws + WS_H), (const float*)(F.ws + WS_ROWSQ), (const float*)(F.ws + WS_BIASF) + (size_t)l * NSEQ * DFF};
            pg8::gemm_phase<pg8::EpiUp, pg8::StaticOrder, true, true>(F.lds + RING_OFF, g, S, E);
        }
        SEAM(pb + 5);
        if (IN(pb + 6) && (PHMASK & 256)) {
            pg8::Gemm g{(const bf16*)(F.ws + WS_H), (const bf16*)(F.ws + WS_WDN) + (size_t)l * DM * DFF, MTOK, DM, DFF}; pg8::StaticOrder S; S.init(MTOK, DM, F.G, (int)blockIdx.x);
            const bool more = (l + 1 < DEPTH);
            pg8::EpiRes E{F.out, F.out + (size_t)NTP * DM, F.out, modl + 5120,
                          more ? INP(IN_GMIX) + (size_t)(l + 1) * DM : nullptr, MOD + (size_t)(l + 1 < DEPTH ? l + 1 : l) * NSEQ * NMOD + 1024, (bf16*)(F.ws + WS_XN), (float*)(F.ws + WS_ROWSQ)};
            pg8::gemm_phase<pg8::EpiRes, pg8::StaticOrder, true, true>(F.lds + RING_OFF, g, S, E);
        }
        SEAM(pb + 6);
        }
    if (IN(PH_FINAL) && (PHMASK & 512)) { for (int m = gw; m < MTOK; m += NGW) final_row(F, m); }
#undef IN
#undef SEAM
}

extern "C" void kernel_launch(void* const* d_in, const int* in_sizes, int n_in, void* d_out, int out_size, void* d_ws, size_t ws_size, hipStream_t stream) {
    static int grid = 0;
    if (grid == 0) {
        if (n_in != 24 || out_size != (int)O_END || ws_size < WS_END) { fprintf(stderr, "kernel_launch: unexpected shapes: n_in %d out %d ws %zu\n", n_in, out_size, ws_size); grid = -1; return; }
        int dev = 0, cus = 0, per_cu = 0;
        if (hipGetDevice(&dev) != hipSuccess || hipDeviceGetAttribute(&cus, hipDeviceAttributeMultiprocessorCount, dev) != hipSuccess) { grid = -1; return; }
        if (hipFuncSetAttribute((const void*)enc_fwd, hipFuncAttributeMaxDynamicSharedMemorySize, LDS_BYTES) != hipSuccess) { fprintf(stderr, "kernel_launch: hipFuncSetAttribute failed\n"); grid = -1; return; }
        if (hipOccupancyMaxActiveBlocksPerMultiprocessor(&per_cu, (const void*)enc_fwd, NWAVES * 64, LDS_BYTES) != hipSuccess || per_cu < 1) { fprintf(stderr, "kernel_launch: occupancy query says %d\n", per_cu); (void)hipGetLastError(); per_cu = 1; }
        grid = cus;
    }
    if (grid < 0) return;
    (void)hipMemsetAsync((char*)d_ws + WS_CTL, 0, CTL_ZERO_BYTES, stream);
    Args a{};
    for (int i = 0; i < 24; ++i) a.in[i] = (const float*)d_in[i];
    a.out = (float*)d_out; a.ws = (unsigned char*)d_ws;
#if MK_ONE_LAUNCH
    a.ph_lo = 0; a.ph_hi = N_PHASES;
    hipLaunchKernelGGL(enc_fwd, dim3(grid), dim3(NWAVES * 64), LDS_BYTES, stream, a);
#else
    for (int p = 0; p < N_PHASES; ++p) { a.ph_lo = p; a.ph_hi = p + 1; hipLaunchKernelGGL(enc_fwd, dim3(grid), dim3(NWAVES * 64), LDS_BYTES, stream, a); }
#endif
}
```

```cpp
#include <hip/hip_runtime.h>
#include <cstdio>
#include <cstdint>
namespace pg8 {
#define PG8_LAS __attribute__((address_space(3)))
typedef unsigned short bf16_t;
typedef short bf16x8 __attribute__((ext_vector_type(8)));
typedef float f32x4 __attribute__((ext_vector_type(4)));
typedef unsigned u32x4 __attribute__((ext_vector_type(4)));
typedef unsigned u32x2 __attribute__((ext_vector_type(2)));
constexpr int BM = 256, BK = 64, HALF = 128, HTB = HALF * BK * 2  , STAGE_BYTES = 8 * HTB, NXCD = 8, WGM = 8;

__host__ __device__ __forceinline__ int lds_byte(int r, int c) { const int st = (r >> 4) * 2 + (c >> 5), rr = r & 15, cc = c & 31, ob = rr * 64 + cc * 2; return st * 1024 + (ob ^ (((ob >> 9) & 1) << 5)); }
__host__ __device__ __forceinline__ void stage_rc(int b, int& R, int& C) { const int st = b / 1024, sb = b % 1024, swz = sb ^ (((sb >> 9) & 1) << 5); R = (st >> 1) * 16 + swz / 64; C = (st & 1) * 32 + (swz % 64) / 2; }
__host__ __device__ __forceinline__ int perm32(int rho) { const int n = rho >> 4, i = rho & 15; return 8 * (i >> 2) + 4 * n + (i & 3); }

struct Unit { int pm, pn; };
struct Gemm { const bf16_t* A; const bf16_t* Bt; int M, N, K; };

struct StaticOrder {
    int nM, nN, nwg, G, c;
    __host__ __device__ void init(int M, int N, int G_, int c_) { nM = M / BM; nN = N / BM; nwg = nM * nN; G = G_; c = c_; }
    __host__ __device__ bool next(int i, Unit& u) const {
        const long L = (long)i * G + c; if (L >= nwg) return false;
        int wgid = (int)L; { const int q = nwg / NXCD, r = nwg % NXCD, xcd = wgid % NXCD, off = wgid / NXCD; wgid = (xcd < r ? xcd * (q + 1) : r * (q + 1) + (xcd - r) * q) + off; }
        const int nig = WGM * nN, gid = wgid / nig, fm = gid * WGM, gsz = (nM - fm) < WGM ? (nM - fm) : WGM;
        u.pm = fm + ((wgid % nig) % gsz); u.pn = (wgid % nig) / gsz; return true;
    }
    __device__ __forceinline__ void a_ready(const Unit&) const {}
    __device__ __forceinline__ void done(const Unit&) const {}
};

__device__ __forceinline__ unsigned cvt_pk_bf16(float lo, float hi) { unsigned r; asm volatile("v_cvt_pk_bf16_f32 %0, %1, %2" : "=v"(r) : "v"(lo), "v"(hi)); return r; }

constexpr int NTOK_P = 16384, D_MODEL = 1024, PLD = 2816, NMOD = 6144, NIN_PAD = 3072, DFF = 4096;
constexpr float NEPS = 1e-6f;
__device__ __forceinline__ int seq_of_row(int r) { return r < NTOK_P ? 0 : 1 + ((r - NTOK_P) >> 6); }
__device__ __forceinline__ float rstd_of(const float* rsq) {
    const f32x4 a = *(const f32x4*)rsq, b = *(const f32x4*)(rsq + 4), c = *(const f32x4*)(rsq + 8), d = *(const f32x4*)(rsq + 12);
    const float s = ((a[0] + a[1]) + (a[2] + a[3])) + ((b[0] + b[1]) + (b[2] + b[3])) + ((c[0] + c[1]) + (c[2] + c[3])) + ((d[0] + d[1]) + (d[2] + d[3]));
    return 1.0f / sqrtf(s * (1.0f / D_MODEL) + NEPS);
}


struct EpiProj {
    static constexpr bool PERM = true, AFTER_DRAIN = false;
    bf16_t* proj; float* ra; const float* rowsq; const float* bias;
    __device__ __forceinline__ void operator()(const f32x4 (&acc)[2][2][4][2], const Unit& u, int wr, int wc, int fr, int fq) const {
#pragma unroll
        for (int ai = 0; ai < 2; ++ai) {
            const int rowb = u.pm * BM + ai * HALF + wr * 64; const int s = seq_of_row(rowb);
            const int colt = u.pn * BM + wc * 32 + 8 * fq;
            const float* bs = bias + (size_t)s * NIN_PAD + colt;
            f32x4 bv[2][2];
#pragma unroll
            for (int bj = 0; bj < 2; ++bj)
#pragma unroll
                for (int n = 0; n < 2; ++n) bv[bj][n] = *(const f32x4*)(bs + bj * HALF + 4 * n);
#pragma unroll
            for (int m = 0; m < 4; ++m) { const int r = rowb + m * 16 + fr; const float rs = rstd_of(rowsq + (size_t)r * 16);
#pragma unroll
                for (int bj = 0; bj < 2; ++bj) { const f32x4 v0 = acc[ai][bj][m][0] * rs + bv[bj][0], v1 = acc[ai][bj][m][1] * rs + bv[bj][1];
                    if (u.pn < 11) { u32x4 w; w.x = cvt_pk_bf16(v0[0], v0[1]); w.y = cvt_pk_bf16(v0[2], v0[3]); w.z = cvt_pk_bf16(v1[0], v1[1]); w.w = cvt_pk_bf16(v1[2], v1[3]);
                        *(u32x4*)(proj + (size_t)r * PLD + colt + bj * HALF) = w; }
                    else if (bj == 0 && wc == 0 && fq < 2) { *(f32x4*)(ra + (size_t)r * 16 + 8 * fq) = v0; *(f32x4*)(ra + (size_t)r * 16 + 8 * fq + 4) = v1; } } }
        }
    }
};
struct EpiUp {
    static constexpr bool PERM = true, AFTER_DRAIN = false;
    bf16_t* H; const float* rowsq; const float* bias;
    __device__ __forceinline__ void operator()(const f32x4 (&acc)[2][2][4][2], const Unit& u, int wr, int wc, int fr, int fq) const {
#pragma unroll
        for (int ai = 0; ai < 2; ++ai) {
            const int rowb = u.pm * BM + ai * HALF + wr * 64; const int s = seq_of_row(rowb);
            const int colt = u.pn * BM + wc * 32 + 8 * fq;
            const float* bs = bias + (size_t)s * DFF + colt;
            f32x4 bv[2][2];
#pragma unroll
            for (int bj = 0; bj < 2; ++bj)
#pragma unroll
                for (int n = 0; n < 2; ++n) bv[bj][n] = *(const f32x4*)(bs + bj * HALF + 4 * n);
#pragma unroll
            for (int m = 0; m < 4; ++m) { const int r = rowb + m * 16 + fr; const float rs = rstd_of(rowsq + (size_t)r * 16);
#pragma unroll
                for (int bj = 0; bj < 2; ++bj) { f32x4 v0 = acc[ai][bj][m][0] * rs + bv[bj][0], v1 = acc[ai][bj][m][1] * rs + bv[bj][1];
#pragma unroll
                    for (int e = 0; e < 4; ++e) { const float a = fmaxf(v0[e], 0.f), b = fmaxf(v1[e], 0.f); v0[e] = a * a; v1[e] = b * b; }
                    u32x4 w; w.x = cvt_pk_bf16(v0[0], v0[1]); w.y = cvt_pk_bf16(v0[2], v0[3]); w.z = cvt_pk_bf16(v1[0], v1[1]); w.w = cvt_pk_bf16(v1[2], v1[3]);
                    *(u32x4*)(H + (size_t)r * DFF + colt + bj * HALF) = w; } }
        }
    }
};
struct EpiRes {
    static constexpr bool PERM = false, AFTER_DRAIN = false;
    const float* basep; const float* bases; float* out; const float* gate;
    const float* gn; const float* scn; bf16_t* xn; float* rowsq;
    __device__ __forceinline__ void operator()(const f32x4 (&acc)[2][2][4][2], const Unit& u, int wr, int wc, int fr, int fq) const {
#pragma unroll
        for (int ai = 0; ai < 2; ++ai) {
            const int rowb = u.pm * BM + ai * HALF + wr * 64; const int s = seq_of_row(rowb);
            const int colt = u.pn * BM + wc * 32 + 4 * fq;
            f32x4 gv[2][2], wv[2][2];
#pragma unroll
            for (int bj = 0; bj < 2; ++bj)
#pragma unroll
                for (int n = 0; n < 2; ++n) { const int c = colt + bj * HALF + 16 * n; gv[bj][n] = *(const f32x4*)(gate + (size_t)s * NMOD + c);
                    if (gn) { const f32x4 g = *(const f32x4*)(gn + c), sc = *(const f32x4*)(scn + (size_t)s * NMOD + c); wv[bj][n] = g * (sc + 1.0f); } else wv[bj][n] = (f32x4){0.f, 0.f, 0.f, 0.f}; }
#pragma unroll
            for (int m = 0; m < 4; ++m) { const int r = rowb + m * 16 + fr;
                const float* bp = (r < NTOK_P) ? basep + (size_t)r * D_MODEL : bases + (size_t)(r - NTOK_P) * D_MODEL;
                float ss = 0.f;
#pragma unroll
                for (int bj = 0; bj < 2; ++bj)
#pragma unroll
                    for (int n = 0; n < 2; ++n) { const int c = colt + bj * HALF + 16 * n;
                        const f32x4 bsv = *(const f32x4*)(bp + c); const f32x4 x1 = bsv + gv[bj][n] * acc[ai][bj][m][n];
                        *(f32x4*)(out + (size_t)r * D_MODEL + c) = x1;
                        ss += (x1[0] * x1[0] + x1[1] * x1[1]) + (x1[2] * x1[2] + x1[3] * x1[3]);
                        if (gn) { const f32x4 y = x1 * wv[bj][n]; u32x2 w; w.x = cvt_pk_bf16(y[0], y[1]); w.y = cvt_pk_bf16(y[2], y[3]); *(u32x2*)(xn + (size_t)r * D_MODEL + c) = w; } }
                ss += __shfl_xor(ss, 16); ss += __shfl_xor(ss, 32);
                if (fq == 0) rowsq[(size_t)r * 16 + u.pn * 4 + wc] = ss;
            }
        }
    }
};
template <class Epi, class Sched, bool ALIGN_EPI = false, bool SP2 = false>
__device__ __forceinline__ void gemm_phase(PG8_LAS unsigned char* lds, const Gemm g, const Sched& S, const Epi& E) {
    const int tid = threadIdx.x, wid = __builtin_amdgcn_readfirstlane(tid >> 6), lane = tid & 63, wr = wid >> 2, wc = wid & 3, fr = lane & 15, fq = lane >> 4;
    const int K = g.K, nt = K / BK;
    unsigned voffA[2], voffB[2];
#pragma unroll
    for (int i = 0; i < 2; ++i) { int R, C; stage_rc(tid * 16 + i * 8192, R, C); const int Rb = Epi::PERM ? ((R & ~31) + perm32(R & 31)) : R;
        voffA[i] = (unsigned)(R * K + C) * 2u; voffB[i] = (unsigned)(Rb * K + C) * 2u; }
    const size_t kstep = (size_t)(BK * 2);
    const size_t hstep = (size_t)HALF * K * 2;
    const size_t tstep = 2 * hstep;
    const unsigned ldsw = (unsigned)wid * 1024u;
    const int aoff = lds_byte(wr * 64 + fr, fq * 8), boff = lds_byte(wc * 32 + fr, fq * 8);
#define PG8_SA(b, h) (((b) * 2 + (h)) * HTB)
#define PG8_SB(b, h) ((4 + (b) * 2 + (h)) * HTB)
#define PG8_STAGE(bufoff, gbase, voff) do { _Pragma("unroll") for (int _i = 0; _i < 2; ++_i) \
        __builtin_amdgcn_global_load_lds((const unsigned*)((const char*)(gbase) + (voff)[_i]), (PG8_LAS unsigned*)(lds + (bufoff) + ldsw + _i * 8192), 16, 0, 0); } while (0)
#define PG8_LDA(dst, b, h) do { _Pragma("unroll") for (int m = 0; m < 4; ++m) _Pragma("unroll") for (int k = 0; k < 2; ++k) dst[m][k] = *(const PG8_LAS bf16x8*)(lds + PG8_SA(b, h) + aoff + m * 2048 + k * 1024); } while (0)
#define PG8_LDB(dst, b, h) do { _Pragma("unroll") for (int n = 0; n < 2; ++n) _Pragma("unroll") for (int k = 0; k < 2; ++k) dst[n][k] = *(const PG8_LAS bf16x8*)(lds + PG8_SB(b, h) + boff + n * 2048 + k * 1024); } while (0)
#define PG8_MMA(ai, bj, At, Bt) do { __builtin_amdgcn_s_setprio(1); _Pragma("unroll") for (int m = 0; m < 4; ++m) _Pragma("unroll") for (int n = 0; n < 2; ++n) _Pragma("unroll") for (int k = 0; k < 2; ++k) \
        acc[ai][bj][m][n] = __builtin_amdgcn_mfma_f32_16x16x32_bf16(Bt[n][k], At[m][k], acc[ai][bj][m][n], 0, 0, 0); __builtin_amdgcn_s_setprio(0); } while (0)
#define PG8_WAIT_V(n) asm volatile("s_waitcnt vmcnt(" #n ")" ::: "memory")
#define PG8_WAIT_L(n) asm volatile("s_waitcnt lgkmcnt(" #n ")" ::: "memory")
#define PG8_BAR __builtin_amdgcn_s_barrier()
#define PG8_SCHED __builtin_amdgcn_sched_barrier(0)
    Unit cur, nxt; int ui = 0;
    if (!S.next(0, cur)) return;
    f32x4 acc[2][2][4][2];
#pragma unroll
    for (int a = 0; a < 2; ++a)
#pragma unroll
        for (int b = 0; b < 2; ++b)
#pragma unroll
            for (int m = 0; m < 4; ++m)
#pragma unroll
                for (int n = 0; n < 2; ++n) acc[a][b][m][n] = (f32x4){0.f, 0.f, 0.f, 0.f};
    bf16x8 At[4][2], B0[2][2], B1[2][2];
    const char* cA = (const char*)g.A + (size_t)cur.pm * tstep; const char* cB = (const char*)g.Bt + (size_t)cur.pn * tstep;
    S.a_ready(cur);
    if constexpr (SP2) {
        PG8_STAGE(PG8_SB(0, 0), cB, voffB); PG8_STAGE(PG8_SB(0, 1), cB + hstep, voffB); PG8_STAGE(PG8_SA(0, 0), cA, voffA); PG8_STAGE(PG8_SA(0, 1), cA + hstep, voffA);
        if (wr == 1) PG8_BAR;
        PG8_WAIT_V(2); PG8_BAR;
        PG8_STAGE(PG8_SB(1, 0), cB + kstep, voffB); PG8_STAGE(PG8_SA(1, 0), cA + kstep, voffA); PG8_STAGE(PG8_SB(1, 1), cB + hstep + kstep, voffB);
        PG8_WAIT_V(6); PG8_BAR;
    } else {
        PG8_STAGE(PG8_SB(0, 0), cB, voffB); PG8_STAGE(PG8_SA(0, 0), cA, voffA); PG8_STAGE(PG8_SB(0, 1), cB + hstep, voffB); PG8_STAGE(PG8_SA(0, 1), cA + hstep, voffA);
        if (wr == 1) PG8_BAR;
        PG8_WAIT_V(4); PG8_BAR;
        PG8_STAGE(PG8_SB(1, 0), cB + kstep, voffB); PG8_STAGE(PG8_SA(1, 0), cA + kstep, voffA); PG8_STAGE(PG8_SB(1, 1), cB + hstep + kstep, voffB);
        PG8_WAIT_V(6); PG8_BAR;
    }
    for (;;) {
        const bool has_next = S.next(ui + 1, nxt);
        const char* nA = has_next ? (const char*)g.A + (size_t)nxt.pm * tstep : cA; const char* nB = has_next ? (const char*)g.Bt + (size_t)nxt.pn * tstep : cB;
        for (int t = 0; t < nt; t += 2) {
            const bool last = (t == nt - 2);
            const char* a1 = cA + (size_t)(t + 1) * kstep;
            const char* a2 = last ? nA : cA + (size_t)(t + 2) * kstep; const char* b2 = last ? nB : cB + (size_t)(t + 2) * kstep;
            const char* a3 = a2 + kstep; const char* b3 = b2 + kstep;
            if (last && has_next) S.a_ready(nxt);
            if constexpr (SP2) {
            PG8_LDB(B0, 0, 0); PG8_LDB(B1, 0, 1); PG8_SCHED; PG8_LDA(At, 0, 0); PG8_STAGE(PG8_SA(1, 1), a1 + hstep, voffA);
            PG8_WAIT_V(8); PG8_WAIT_L(0); PG8_BAR; PG8_MMA(0, 0, At, B0); PG8_MMA(0, 1, At, B1); PG8_BAR; PG8_SCHED;
            PG8_LDA(At, 0, 1); PG8_STAGE(PG8_SB(0, 0), b2, voffB); PG8_STAGE(PG8_SB(0, 1), b2 + hstep, voffB); PG8_STAGE(PG8_SA(0, 0), a2, voffA);
            PG8_WAIT_V(8); PG8_WAIT_L(0); PG8_BAR; PG8_MMA(1, 0, At, B0); PG8_MMA(1, 1, At, B1); PG8_BAR; PG8_SCHED;
            PG8_LDB(B0, 1, 0); PG8_LDB(B1, 1, 1); PG8_SCHED; PG8_LDA(At, 1, 0); PG8_STAGE(PG8_SA(0, 1), a2 + hstep, voffA);
            PG8_WAIT_V(8); PG8_WAIT_L(0); PG8_BAR; PG8_MMA(0, 0, At, B0); PG8_MMA(0, 1, At, B1); PG8_BAR; PG8_SCHED;
            PG8_LDA(At, 1, 1); PG8_STAGE(PG8_SB(1, 0), b3, voffB); PG8_STAGE(PG8_SB(1, 1), b3 + hstep, voffB); PG8_STAGE(PG8_SA(1, 0), a3, voffA);
            PG8_WAIT_V(8); PG8_WAIT_L(0); PG8_BAR; PG8_MMA(1, 0, At, B0); PG8_MMA(1, 1, At, B1); PG8_BAR; PG8_SCHED;
            } else {
            PG8_LDB(B0, 0, 0); PG8_SCHED; PG8_LDA(At, 0, 0); PG8_STAGE(PG8_SA(1, 1), a1 + hstep, voffA);
            PG8_WAIT_L(8); PG8_BAR; PG8_WAIT_L(0); PG8_MMA(0, 0, At, B0); PG8_BAR; PG8_SCHED;
            PG8_LDB(B1, 0, 1); PG8_STAGE(PG8_SB(0, 0), b2, voffB);
            PG8_BAR; PG8_WAIT_L(0); PG8_MMA(0, 1, At, B1); PG8_BAR;
            PG8_LDA(At, 0, 1); PG8_STAGE(PG8_SA(0, 0), a2, voffA);
            PG8_BAR; PG8_WAIT_L(0); PG8_MMA(1, 0, At, B0); PG8_BAR; PG8_SCHED;
            PG8_STAGE(PG8_SB(0, 1), b2 + hstep, voffB);
            PG8_WAIT_V(6); PG8_BAR; PG8_MMA(1, 1, At, B1); PG8_BAR;
            PG8_LDB(B0, 1, 0); PG8_SCHED; PG8_LDA(At, 1, 0); PG8_STAGE(PG8_SA(0, 1), a2 + hstep, voffA);
            PG8_WAIT_L(8); PG8_BAR; PG8_WAIT_L(0); PG8_MMA(0, 0, At, B0); PG8_BAR; PG8_SCHED;
            PG8_LDB(B1, 1, 1); PG8_STAGE(PG8_SB(1, 0), b3, voffB);
            PG8_BAR; PG8_WAIT_L(0); PG8_MMA(0, 1, At, B1); PG8_BAR;
            PG8_LDA(At, 1, 1); PG8_STAGE(PG8_SA(1, 0), a3, voffA);
            PG8_BAR; PG8_WAIT_L(0); PG8_MMA(1, 0, At, B0); PG8_BAR; PG8_SCHED;
            PG8_STAGE(PG8_SB(1, 1), b3 + hstep, voffB);
            PG8_WAIT_V(6); PG8_BAR; PG8_MMA(1, 1, At, B1); PG8_BAR;
            }
        }
        if constexpr (ALIGN_EPI) { if (wr == 0) PG8_BAR; }
        if constexpr (!Epi::AFTER_DRAIN) { E(acc, cur, wr, wc, fr, fq); S.done(cur); }
        if (!has_next) break;
#pragma unroll
        for (int a = 0; a < 2; ++a)
#pragma unroll
            for (int b = 0; b < 2; ++b)
#pragma unroll
                for (int m = 0; m < 4; ++m)
#pragma unroll
                    for (int n = 0; n < 2; ++n) acc[a][b][m][n] = (f32x4){0.f, 0.f, 0.f, 0.f};
        cur = nxt; cA = nA; cB = nB; ++ui;
        if constexpr (ALIGN_EPI) { if (wr == 1) PG8_BAR; }
    }
    PG8_WAIT_V(0);
    if constexpr (!ALIGN_EPI) { if (wr == 0) PG8_BAR; }
    PG8_BAR;
    if constexpr (Epi::AFTER_DRAIN) { E.fused(acc, cur, wr, wc, fr, fq, lds, wid, lane); S.done(cur); }
#undef PG8_SA
#undef PG8_SB
#undef PG8_STAGE
#undef PG8_LDA
#undef PG8_LDB
#undef PG8_MMA
#undef PG8_WAIT_V
#undef PG8_WAIT_L
#undef PG8_BAR
#undef PG8_SCHED
}
}

constexpr int NWAVES = 8;
constexpr int DEPTH = 2, DM = 1024, NTP = 16384, NTS = 2048, MTOK = NTP + NTS, NSEQ = 33, NCHUNK = MTOK / 64;
constexpr int PLD = 2816, NINP = 3072, NIN_SRC = 2832, DFF = 4096, NMOD = 6144;
constexpr float EPS = 1e-6f;
constexpr int C_QA = 0, C_KA = 256, C_VA = 512, C_GA = 1024, C_QB = 1536, C_KB = 1792, C_VB = 1920, C_QC = 2048, C_KC = 2304, C_VC = 2560;
constexpr size_t O_Y = 0, O_SGP = 18874368, O_KBP = 18939904, O_VBP = 18972672, O_KCP = 19005440, O_VCP = 19267584, O_SGS = 19529728,
                 O_KBS = 21626880, O_VBS = 22675456, O_KCS = 23724032, O_VCS = 32112640, O_END = 40501248;
constexpr size_t MiB = 1u << 20;
constexpr size_t WS_CTL = 0, CTL_ZERO_BYTES = 1 * MiB;
constexpr size_t WS_MOD = 1 * MiB, WS_BIASM = 3 * MiB, WS_BIASF = 4 * MiB, WS_ROWSQ = 6 * MiB, WS_RA = 8 * MiB, WS_DN = 10 * MiB;
constexpr size_t WS_WIN = 12 * MiB, WS_WOUT = 24 * MiB, WS_WUP = 28 * MiB, WS_WDN = 44 * MiB;
constexpr size_t WS_XN = 60 * MiB;
constexpr size_t WS_PROJ = 96 * MiB;
constexpr size_t WS_MIXED = 195 * MiB;
constexpr size_t WS_SST = 231 * MiB;
constexpr size_t WS_H = 96 * MiB;
constexpr size_t WS_END = 249 * MiB;
constexpr int CW_TMO = 0, CW_CODE = 1, CW_BAR = 4096, CW_Q = 16384;
constexpr int RING_OFF = 0, RING_BYTES = 131072;
constexpr int LDSCTL_OFF = 160 * 1024 - 1024, MISC_OFF = LDSCTL_OFF + 320, TBL_OFF = LDSCTL_OFF + 512;
constexpr int LDS_BYTES = 160 * 1024;

#define GAS __attribute__((address_space(1)))
#define LAS __attribute__((address_space(3)))
typedef unsigned short bf16;
typedef unsigned v4u __attribute__((ext_vector_type(4)));
typedef unsigned v2u __attribute__((ext_vector_type(2)));
typedef float f32x4 __attribute__((ext_vector_type(4)));
typedef GAS unsigned gu32;
#define RLX_AGENT __ATOMIC_RELAXED, __HIP_MEMORY_SCOPE_AGENT
#define LDS_WAIT() asm volatile("s_waitcnt lgkmcnt(0)" ::: "memory")
#define VM_WAIT() asm volatile("s_waitcnt vmcnt(0)" ::: "memory")
__device__ __forceinline__ unsigned f2bf(float f) { unsigned u = __builtin_bit_cast(unsigned, f); return (u + 0x7fffu + ((u >> 16) & 1u)) >> 16; }
__device__ __forceinline__ unsigned pk2(float lo, float hi) { return f2bf(lo) | (f2bf(hi) << 16); }
__device__ __forceinline__ float bf2f(unsigned short h) { return __builtin_bit_cast(float, (unsigned)h << 16); }
__device__ __forceinline__ float bflo(unsigned w) { return __builtin_bit_cast(float, w << 16); }
__device__ __forceinline__ float bfhi(unsigned w) { return __builtin_bit_cast(float, w & 0xffff0000u); }
__device__ __forceinline__ float wave_sum(float v) {
#pragma unroll
    for (int o = 1; o < 64; o <<= 1) v += __shfl_xor(v, o);
    return v;
}
__device__ __forceinline__ float wave_max(float v) {
#pragma unroll
    for (int o = 1; o < 64; o <<= 1) v = fmaxf(v, __shfl_xor(v, o));
    return v;
}
__device__ __forceinline__ float silu_f(float x) { return x / (1.0f + __expf(-x)); }
__device__ __forceinline__ float logsigmoid_f(float x) { return fminf(x, 0.f) - log1pf(__expf(-fabsf(x))); }
#define XB_TMO      128
#define XB_XCNT(j)  (256  + 64 * (j))
#define XB_XSUB(j)  (1280 + 64 * (j))
#define XB_XGEN(j)  (2304 + 64 * (j))
#define XB_TOP      3328
#define XB_TOPGEN   3392
#define XCD_BAR_WORDS 3456
#define XB_SPIN_CAP (1u << 24)

__device__ __forceinline__ unsigned xb_ld(unsigned* p)              { return __hip_atomic_load(p, __ATOMIC_RELAXED, __HIP_MEMORY_SCOPE_AGENT); }
__device__ __forceinline__ unsigned xb_add(unsigned* p, unsigned v) { return __hip_atomic_fetch_add(p, v, __ATOMIC_RELAXED, __HIP_MEMORY_SCOPE_AGENT); }
__device__ __forceinline__ unsigned xb_xcc_id() { return (unsigned)__builtin_amdgcn_s_getreg((3 << 11) | 20) & 0xFu; }
#define XB_SPIN(cond, bar) do { unsigned _sp = 0; while (cond) { __builtin_amdgcn_s_sleep(1); \
    if ((++_sp & 255u) == 0u) { if (xb_ld(&(bar)[XB_TMO])) break; if (_sp > XB_SPIN_CAP) { atomicAdd(&(bar)[XB_TMO], 1u); break; } } } } while (0)

struct XcdBarrier {
    unsigned* bar; unsigned x;
    volatile LAS unsigned* st;
};

__device__ __forceinline__ XcdBarrier xcd_barrier_post(unsigned* bar, volatile LAS unsigned* st) {
    XcdBarrier b; b.bar = bar; b.x = xb_xcc_id(); b.st = st;
    if (threadIdx.x == 0) (void)xb_add(&bar[XB_XCNT(b.x)], 1u);
    return b;
}
__device__ __forceinline__ void xcd_barrier_complete(unsigned* bar, unsigned x, unsigned& nloc, unsigned& nx) {
    const unsigned G = gridDim.x * gridDim.y * gridDim.z;
    unsigned sum, cnt, mine, sp = 0u;
    for (;;) {
        sum = 0u; cnt = 0u; mine = 0u;
#pragma unroll
        for (unsigned j = 0; j < 16; ++j) { const unsigned c = xb_ld(&bar[XB_XCNT(j)]); sum += c; cnt += (c > 0u) ? 1u : 0u; mine = (j == x) ? c : mine; }
        if (sum == G) break;
        __builtin_amdgcn_s_sleep(1);
        if ((++sp & 255u) == 0u) { if (xb_ld(&bar[XB_TMO])) break; if (sp > XB_SPIN_CAP) { atomicAdd(&bar[XB_TMO], 1u); break; } }
    }
    nloc = mine > 0u ? mine : 1u; nx = cnt > 0u ? cnt : 1u;
}

__device__ __forceinline__ void xcd_barrier(const XcdBarrier& b) {
    asm volatile("s_waitcnt vmcnt(0)" ::: "memory");
    __syncthreads();
    if (threadIdx.x == 0) {
        unsigned* bar = b.bar;
        __builtin_amdgcn_s_waitcnt(0);
        unsigned nloc = b.st[0], nx = b.st[1];
        if (nloc == 0u) { xcd_barrier_complete(bar, b.x, nloc, nx); b.st[0] = nloc; b.st[1] = nx; }
        const unsigned old = xb_add(&bar[XB_XSUB(b.x)], 1u);
        const unsigned gen = old / nloc;
        if (old + 1u == (gen + 1u) * nloc) {
            __builtin_amdgcn_fence(__ATOMIC_RELEASE, "agent");
            asm volatile("s_waitcnt vmcnt(0)" ::: "memory");
            const unsigned og = xb_add(&bar[XB_TOP], 1u);
            const unsigned tg = og / nx;
            if (og + 1u == (tg + 1u) * nx) xb_add(&bar[XB_TOPGEN], 1u);
            else XB_SPIN(xb_ld(&bar[XB_TOPGEN]) == tg, bar);
            __builtin_amdgcn_fence(__ATOMIC_ACQUIRE, "agent");
            xb_add(&bar[XB_XGEN(b.x)], 1u);
            asm volatile("s_waitcnt vmcnt(0)" ::: "memory");
        } else {
            XB_SPIN(xb_ld(&bar[XB_XGEN(b.x)]) == gen, bar);
            __builtin_amdgcn_fence(__ATOMIC_ACQUIRE, "agent");
            asm volatile("s_waitcnt vmcnt(0)" ::: "memory");
        }
    }
    __syncthreads();
}

struct Args { const float* in[24]; float* out; unsigned char* ws; int ph_lo, ph_hi; };
static_assert(sizeof(Args) == 24 * 8 + 8 + 8 + 8, "Args has no padding");
__device__ __forceinline__ const float* inp_ptr(LAS unsigned char* lds, int i) {
    const unsigned long long v = ((const volatile LAS unsigned long long*)(lds + TBL_OFF))[i];
    const unsigned lo = __builtin_amdgcn_readfirstlane((unsigned)v), hi = __builtin_amdgcn_readfirstlane((unsigned)(v >> 32));
    return (const float*)(((unsigned long long)hi << 32) | lo);
}
#define INP(i) inp_ptr(F.lds, (i))
struct Frame {
    LAS unsigned char* lds;
    volatile LAS unsigned* MISC;
    gu32* ctl;
    int tid, lane, wave, vcu, G;
    float* out; unsigned char* ws;
};
#define IN_XP 0
#define IN_XS 1
#define IN_CP 2
#define IN_CS 3
#define IN_SG 4
#define IN_CBK 5
#define IN_CBV 6
#define IN_CCK 7
#define IN_CCV 8
#define IN_WADA 9
#define IN_BADA 10
#define IN_GMIX 11
#define IN_GMLP 12
#define IN_WIN 13
#define IN_WA2 14
#define IN_BA2 15
#define IN_ANG 16
#define IN_SINK 17
#define IN_T5 18
#define IN_CREL 19
#define IN_WOUT 20
#define IN_WUP 21
#define IN_WDN 22
#define IN_GFIN 23

__device__ __forceinline__ int win_colmap(int n) { return n < 1536 ? n : (n < 2816 ? n + 16 : (n < 2832 ? n - 2816 + 1536 : -1)); }
template <bool WINMAP>
__device__ __forceinline__ void p0_transpose_item(const float* W, int K, int Nsrc, int Npad, bf16* WT, LAS float* scr, int item, int lane) {
    const int nblk = Npad / 32, kb = item / nblk, nb = item % nblk, k0 = 64 * kb, n0 = 32 * nb;
    const int nn = n0 + (lane & 31); const int sc = WINMAP ? win_colmap(nn) : nn;
#pragma unroll 8
    for (int i = 0; i < 32; ++i) { const int kk = 2 * i + (lane >> 5); scr[kk * 33 + (lane & 31)] = (sc >= 0) ? W[(size_t)(k0 + kk) * Nsrc + sc] : 0.f; }
    LDS_WAIT(); asm volatile("" ::: "memory");
    const int c = lane & 7;
#pragma unroll
    for (int j = 0; j < 4; ++j) { const int n = (lane >> 3) + 8 * j; const LAS float* s = scr + (8 * c) * 33 + n;
        v4u o; o.x = pk2(s[0 * 33], s[1 * 33]); o.y = pk2(s[2 * 33], s[3 * 33]); o.z = pk2(s[4 * 33], s[5 * 33]); o.w = pk2(s[6 * 33], s[7 * 33]);
        *(GAS v4u*)(WT + (size_t)(n0 + n) * K + k0 + 8 * c) = o; }
    LDS_WAIT(); asm volatile("" ::: "memory");
}
__device__ __forceinline__ void p0_transposes(Frame& F) {
    LAS float* scr = (LAS float*)(F.lds + RING_OFF + F.wave * 16384);
    const int gw = F.vcu * NWAVES + F.wave, NGW = F.G * NWAVES;
    constexpr int I_IN = 16 * 96, I_OUT = 16 * 32, I_UP = 16 * 128, I_DN = 64 * 32, I_L = I_IN + I_OUT + I_UP + I_DN;
    for (int it = gw; it < DEPTH * I_L; it += NGW) {
        const int l = it / I_L; int r = it % I_L;
        if (r < I_IN) { p0_transpose_item<true>(INP(IN_WIN) + (size_t)l * DM * NIN_SRC, DM, NIN_SRC, NINP, (bf16*)(F.ws + WS_WIN) + (size_t)l * NINP * DM, scr, r, F.lane); continue; } r -= I_IN;
        if (r < I_OUT) { p0_transpose_item<false>(INP(IN_WOUT) + (size_t)l * DM * DM, DM, DM, DM, (bf16*)(F.ws + WS_WOUT) + (size_t)l * DM * DM, scr, r, F.lane); continue; } r -= I_OUT;
        if (r < I_UP) { p0_transpose_item<false>(INP(IN_WUP) + (size_t)l * DM * DFF, DM, DFF, DFF, (bf16*)(F.ws + WS_WUP) + (size_t)l * DFF * DM, scr, r, F.lane); continue; } r -= I_UP;
        p0_transpose_item<false>(INP(IN_WDN) + (size_t)l * DFF * DM, DFF, DM, DM, (bf16*)(F.ws + WS_WDN) + (size_t)l * DM * DFF, scr, r, F.lane);
    }
}
template <int MODE>
__device__ __forceinline__ void skinny_item(Frame& F, int l, int item) {
    LAS float* A = (LAS float*)(F.lds);
    LAS float* RED = (LAS float*)(F.lds + 73728);
    const int n0 = item * 64, col = n0 + F.lane;
    const float* W; int ldw, scol; float* out; int ldo; float addb = 0.f;
    float* MOD = (float*)(F.ws + WS_MOD) + (size_t)l * NSEQ * NMOD;
    if (MODE == 0) { W = INP(IN_WADA) + (size_t)l * DM * NMOD; ldw = NMOD; scol = col; out = MOD; ldo = NMOD; }
    else if (MODE == 1) { W = INP(IN_WIN) + (size_t)l * DM * NIN_SRC; ldw = NIN_SRC; scol = win_colmap(col); out = (float*)(F.ws + WS_BIASM) + (size_t)l * NSEQ * NINP; ldo = NINP; }
    else { W = INP(IN_WUP) + (size_t)l * DM * DFF; ldw = DFF; scol = col; out = (float*)(F.ws + WS_BIASF) + (size_t)l * NSEQ * DFF; ldo = DFF; }
    float acc[36];
#pragma unroll
    for (int s = 0; s < 36; ++s) acc[s] = 0.f;
    for (int kh = 0; kh < 2; ++kh) {
        __syncthreads();
        { const int kk = F.tid, k = 512 * kh + kk;
#pragma unroll 1
          for (int s = 0; s < NSEQ; ++s) { float a;
              if (MODE == 0) { const float c = (s == 0) ? INP(IN_CP)[k] : INP(IN_CS)[(size_t)(s - 1) * DM + k]; a = silu_f(c); }
              else a = MOD[(size_t)s * NMOD + (MODE == 1 ? 0 : 3072) + k];
              A[kk * 36 + s] = a; }
          A[kk * 36 + 33] = 0.f; A[kk * 36 + 34] = 0.f; A[kk * 36 + 35] = 0.f; }
        __syncthreads();
        const int kb = F.wave * 64;
#pragma unroll 4
        for (int kk = kb; kk < kb + 64; ++kk) {
            const float wv = (scol >= 0) ? W[(size_t)(512 * kh + kk) * ldw + scol] : 0.f;
#pragma unroll
            for (int s4 = 0; s4 < 9; ++s4) { const f32x4 a4 = *(const LAS f32x4*)(A + kk * 36 + 4 * s4);
                acc[4 * s4 + 0] += a4[0] * wv; acc[4 * s4 + 1] += a4[1] * wv; acc[4 * s4 + 2] += a4[2] * wv; acc[4 * s4 + 3] += a4[3] * wv; }
        }
    }
#pragma unroll
    for (int s = 0; s < NSEQ; ++s) RED[(F.wave * NSEQ + s) * 64 + F.lane] = acc[s];
    __syncthreads();
    for (int idx = F.tid; idx < NSEQ * 64; idx += NWAVES * 64) { const int s = idx >> 6, ln = idx & 63; float sum = 0.f;
#pragma unroll
        for (int w = 0; w < NWAVES; ++w) sum += RED[(w * NSEQ + s) * 64 + ln];
        if (MODE == 0) sum += INP(IN_BADA)[(size_t)l * NMOD + n0 + ln];
        out[(size_t)s * ldo + n0 + ln] = sum; }
    __syncthreads();
}
__device__ __forceinline__ void xn0_row(Frame& F, int m) {
    const float* xrow = (m < NTP) ? INP(IN_XP) + (size_t)m * DM : INP(IN_XS) + (size_t)(m - NTP) * DM;
    const int s = m < NTP ? 0 : 1 + ((m - NTP) >> 6);
    const float* sc = (const float*)(F.ws + WS_MOD) + (size_t)s * NMOD + 1024; const float* g = INP(IN_GMIX);
    bf16* orow = (bf16*)(F.ws + WS_XN) + (size_t)m * DM;
    float ss = 0.f;
#pragma unroll
    for (int j = 0; j < 4; ++j) { const int c = 4 * (F.lane + 64 * j); const f32x4 v = *(const f32x4*)(xrow + c), gg = *(const f32x4*)(g + c), s4 = *(const f32x4*)(sc + c);
        ss += (v[0] * v[0] + v[1] * v[1]) + (v[2] * v[2] + v[3] * v[3]);
        const f32x4 y = v * (gg * (s4 + 1.0f)); v2u w; w.x = pk2(y[0], y[1]); w.y = pk2(y[2], y[3]); *(v2u*)(orow + c) = w; }
    ss = wave_sum(ss);
    if (F.lane < 16) ((float*)(F.ws + WS_ROWSQ))[(size_t)m * 16 + F.lane] = (F.lane == 0) ? ss : 0.f;
}
__device__ __forceinline__ void final_row(Frame& F, int m) {
    float* xrow = F.out + (size_t)m * DM; const float* g = INP(IN_GFIN);
    const float rs = pg8::rstd_of((const float*)(F.ws + WS_ROWSQ) + (size_t)m * 16);
#pragma unroll
    for (int j = 0; j < 4; ++j) { const int c = 4 * (F.lane + 64 * j); const f32x4 v = *(const f32x4*)(xrow + c), gg = *(const f32x4*)(g + c); *(f32x4*)(xrow + c) = v * rs * gg; }
}

__device__ __forceinline__ int t5_bucket_dev(int rel) {
    const int n = rel < 0 ? -rel : rel; int b;
    if (n < 8) b = n; else { const int lg = 31 - __clz(n * n); int large = 2 + lg; if (large > 15) large = 15; b = large; }
    return (rel > 0 ? 16 : 0) + b;
}
template <int MIX>
__device__ __forceinline__ void attn_simple(Frame& F, int l) {
    constexpr int T0 = MIX ? 8 : 2, NT = T0 + 1, LC = 64 * T0, NKV = MIX ? 4 : 2;
    constexpr int QC = MIX ? C_QC : C_QB, KC = MIX ? C_KC : C_KB, VC = MIX ? C_VC : C_VB, OC = MIX ? 768 : 512;
    const bf16* proj = (const bf16*)(F.ws + WS_PROJ); bf16* mixed = (bf16*)(F.ws + WS_MIXED);
    const float* ck = (MIX ? INP(IN_CCK) : INP(IN_CBK)) + (size_t)l * 32 * LC * NKV * 64; const float* cv = (MIX ? INP(IN_CCV) : INP(IN_CBV)) + (size_t)l * 32 * LC * NKV * 64;
    const float* t5 = INP(IN_T5); const float* crel = INP(IN_CREL) + (size_t)l * 513 * 4; const float* sinkp = INP(IN_SINK) + l * 4;
    const int gw = F.vcu * NWAVES + F.wave, NGW = F.G * NWAVES, lane = F.lane;
    for (int task = gw; task < MTOK * 4; task += NGW) {
        const int m = task >> 2, h = task & 3, kvh = MIX ? h : (h >> 1);
        const bool isp = m < NTP; const int q = m & 63; const int n = m >> 6; const int b = (m - NTP) >> 6;
        const float qd = bf2f(proj[(size_t)m * PLD + QC + 64 * h + lane]);
        LAS float* scl = (LAS float*)(F.lds) + F.wave * 640;
        float mx = -1e30f;
#pragma unroll 1
        for (int i = 0; i < NT; ++i) {
            const int j = lane + 64 * i; float dot = 0.f; bool valid = true;
            if (isp || i == T0) {
                const long tok = isp ? (long)64 * (n - T0) + j : (long)NTP + 64 * b + (j - LC);
                valid = tok >= 0;
                const v4u* kp = (const v4u*)(proj + (size_t)(valid ? tok : 0) * PLD + KC + 64 * kvh);
#pragma unroll 2
                for (int c = 0; c < 8; ++c) { const v4u kv = kp[c];
                    const unsigned w[4] = {kv.x, kv.y, kv.z, kv.w};
#pragma unroll
                    for (int e = 0; e < 4; ++e) { dot += __shfl(qd, 8 * c + 2 * e) * bflo(w[e]); dot += __shfl(qd, 8 * c + 2 * e + 1) * bfhi(w[e]); } }
            } else {
                const f32x4* kp = (const f32x4*)(ck + (((size_t)b * LC + j) * NKV + kvh) * 64);
#pragma unroll 2
                for (int c = 0; c < 16; ++c) { const f32x4 kv = kp[c];
#pragma unroll
                    for (int e = 0; e < 4; ++e) dot += __shfl(qd, 4 * c + e) * kv[e]; }
            }
            const int rel = j - LC - q; float bias;
            if (MIX) { int rc = rel < -256 ? -256 : (rel > 256 ? 256 : rel); bias = crel[(rc + 256) * 4 + h]; }
            else bias = t5[t5_bucket_dev(rel) * 4 + h];
            const float sv = valid ? dot * 0.125f + bias : -1e30f;
            scl[j] = sv; mx = fmaxf(mx, sv);
        }
        mx = wave_max(mx);
        float sk = 0.f; if (!MIX) { sk = sinkp[h]; mx = fmaxf(mx, sk); }
        float sum = 0.f;
#pragma unroll 1
        for (int i = 0; i < NT; ++i) { const float p = __expf(scl[lane + 64 * i] - mx); scl[lane + 64 * i] = p; sum += p; }
        sum = wave_sum(sum); if (!MIX) sum += __expf(sk - mx);
        const float inv = 1.0f / sum;
        LDS_WAIT();
        float o = 0.f;
#pragma unroll 1
        for (int i = 0; i < NT; ++i) {
            if (isp || i == T0) {
                const long tok0 = isp ? (long)64 * (n - T0 + i) : (long)NTP + 64 * b;
                if (tok0 >= 0) {
                    const bf16* vp = proj + (size_t)tok0 * PLD + VC + 64 * kvh + lane;
#pragma unroll 8
                    for (int jj = 0; jj < 64; ++jj) o += scl[64 * i + jj] * bf2f(vp[(size_t)jj * PLD]);
                }
            } else {
                const float* vp = cv + (((size_t)b * LC + 64 * i) * NKV + kvh) * 64 + lane;
#pragma unroll 8
                for (int jj = 0; jj < 64; ++jj) o += scl[64 * i + jj] * vp[(size_t)jj * NKV * 64];
            }
        }
        LDS_WAIT();
        mixed[(size_t)m * DM + OC + 64 * h + lane] = (bf16)f2bf(o * inv);
    }
}
__device__ __forceinline__ void cache_out_simple(Frame& F, int l) {
    const bf16* proj = (const bf16*)(F.ws + WS_PROJ);
    const size_t gt = (size_t)F.vcu * NWAVES * 64 + F.tid, NGT = (size_t)F.G * NWAVES * 64;
    for (size_t i = gt; i < 2 * 16384; i += NGT) { const int kv = (int)(i / 16384), e = (int)(i % 16384), row = e / 128, c = e % 128;
        F.out[(kv ? O_VBP : O_KBP) + (size_t)l * 16384 + e] = bf2f(proj[(size_t)(NTP - 128 + row) * PLD + (kv ? C_VB : C_KB) + c]); }
    for (size_t i = gt; i < 2 * 131072; i += NGT) { const int kv = (int)(i / 131072), e = (int)(i % 131072), row = e / 256, c = e % 256;
        F.out[(kv ? O_VCP : O_KCP) + (size_t)l * 131072 + e] = bf2f(proj[(size_t)(NTP - 512 + row) * PLD + (kv ? C_VC : C_KC) + c]); }
    for (size_t i = gt; i < 2 * 524288; i += NGT) { const int kv = (int)(i / 524288), e = (int)(i % 524288), b = e / 16384, row = (e % 16384) / 128, c = e % 128;
        float v;
        if (row < 64) v = (kv ? INP(IN_CBV) : INP(IN_CBK))[(size_t)l * 524288 + (size_t)b * 16384 + (size_t)(row + 64) * 128 + c];
        else v = bf2f(proj[(size_t)(NTP + 64 * b + row - 64) * PLD + (kv ? C_VB : C_KB) + c]);
        F.out[(kv ? O_VBS : O_KBS) + (size_t)l * 524288 + e] = v; }
    for (size_t i = gt; i < 2 * 4194304; i += NGT) { const int kv = (int)(i / 4194304), e = (int)(i % 4194304), b = e / 131072, row = (e % 131072) / 256, c = e % 256;
        float v;
        if (row < 448) v = (kv ? INP(IN_CCV) : INP(IN_CCK))[(size_t)l * 4194304 + (size_t)b * 131072 + (size_t)(row + 64) * 256 + c];
        else v = bf2f(proj[(size_t)(NTP + 64 * b + row - 448) * PLD + (kv ? C_VC : C_KC) + c]);
        F.out[(kv ? O_VCS : O_KCS) + (size_t)l * 4194304 + e] = v; }
}
__device__ __forceinline__ void gla_simple(Frame& F, int l) {
    const bf16* proj = (const bf16*)(F.ws + WS_PROJ); const float* RA = (const float*)(F.ws + WS_RA); float* OG = (float*)(F.ws + WS_XN);
    const int gw = F.vcu * NWAVES + F.wave, NGW = F.G * NWAVES, lane = F.lane;
    for (int task = gw; task < NSEQ * 512; task += NGW) {
        const int s = task / 512, h = (task % 512) / 128, dv = task % 128;
        const int row0 = s == 0 ? 0 : NTP + 64 * (s - 1), nrow = s == 0 ? NTP : 64;
        float S = s == 0 ? 0.f : INP(IN_SG)[((((size_t)l * 32 + (s - 1)) * 4 + h) * 64 + lane) * 128 + dv];
        float wc[16];
#pragma unroll
        for (int r = 0; r < 16; ++r) wc[r] = INP(IN_WA2)[((size_t)l * 16 + r) * 256 + h * 64 + lane];
        const float ba = INP(IN_BA2)[(size_t)l * 256 + h * 64 + lane];
#pragma unroll 4
        for (int t = 0; t < nrow; ++t) {
            const int m = row0 + t; const float* ra = RA + (size_t)m * 16;
            float x = ba;
#pragma unroll
            for (int r = 0; r < 16; ++r) x += ra[r] * wc[r];
            const float alpha = __expf(logsigmoid_f(x) * (1.0f / 16.0f));
            const float qv = bf2f(proj[(size_t)m * PLD + C_QA + 64 * h + lane]) * 0.125f, kv = bf2f(proj[(size_t)m * PLD + C_KA + 64 * h + lane]);
            const float vv = bf2f(proj[(size_t)m * PLD + C_VA + 128 * h + dv]);
            S = alpha * S + kv * vv;
            const float o = wave_sum(qv * S);
            if (lane == 0) OG[(size_t)m * 512 + h * 128 + dv] = o;
        }
        float* so = F.out + (s == 0 ? O_SGP + (size_t)l * 32768 : O_SGS + ((size_t)l * 32 + (s - 1)) * 32768);
        so[((size_t)h * 64 + lane) * 128 + dv] = S;
    }
}
__device__ __forceinline__ void gla_norm_simple(Frame& F, int l) {
    const bf16* proj = (const bf16*)(F.ws + WS_PROJ); const float* OG = (const float*)(F.ws + WS_XN); bf16* mixed = (bf16*)(F.ws + WS_MIXED);
    const float* ng = INP(IN_ANG) + l * 128;
    const int gw = F.vcu * NWAVES + F.wave, NGW = F.G * NWAVES, lane = F.lane;
    for (int task = gw; task < MTOK * 4; task += NGW) {
        const int m = task >> 2, h = task & 3;
        const float o0 = OG[(size_t)m * 512 + h * 128 + lane], o1 = OG[(size_t)m * 512 + h * 128 + 64 + lane];
        const float ss = wave_sum(o0 * o0 + o1 * o1); const float rs = 1.0f / sqrtf(ss * (1.0f / 128.0f) + EPS);
        const float g0 = bf2f(proj[(size_t)m * PLD + C_GA + 128 * h + lane]), g1 = bf2f(proj[(size_t)m * PLD + C_GA + 128 * h + 64 + lane]);
        mixed[(size_t)m * DM + h * 128 + lane] = (bf16)f2bf(o0 * rs * ng[lane] * silu_f(g0));
        mixed[(size_t)m * DM + h * 128 + 64 + lane] = (bf16)f2bf(o1 * rs * ng[64 + lane] * silu_f(g1));
    }
}

typedef short bf16x8v __attribute__((ext_vector_type(8)));
typedef short s16x4v __attribute__((ext_vector_type(4)));
typedef float f32x16 __attribute__((ext_vector_type(16)));
constexpr int AT_K = 0, AT_V = 36864, AT_BTC = 86016, AT_BTB = 96256, AT_WS = 100352, AT_QW = 102400;
constexpr float LOG2E = 1.4426950408889634f;
__device__ __forceinline__ int crow16(int r, int hi) { return (r & 3) + 8 * (r >> 2) + 4 * hi; }
__device__ __forceinline__ s16x4v ds_tr16(const LAS unsigned char* p) { return __builtin_bit_cast(s16x4v, __builtin_amdgcn_ds_read_tr16_b64_v4i16((LAS s16x4v*)p)); }
__device__ __forceinline__ unsigned cvtpk(float lo, float hi) { unsigned r; asm volatile("v_cvt_pk_bf16_f32 %0, %1, %2" : "=v"(r) : "v"(lo), "v"(hi)); return r; }

__device__ __forceinline__ void attn_build_tables(Frame& F, int l) {
    const float* crel = INP(IN_CREL) + (size_t)l * 513 * 4; const float* t5 = INP(IN_T5);
    LAS float* bc = (LAS float*)(F.lds + AT_BTC); LAS float* bb = (LAS float*)(F.lds + AT_BTB);
    for (int i = F.tid; i < 4 * 640; i += NWAVES * 64) { const int h = i / 640, idx = i % 640; int rel = idx - 575; rel = rel < -256 ? -256 : (rel > 256 ? 256 : rel); bc[i] = crel[(rel + 256) * 4 + h] * LOG2E; }
    for (int i = F.tid; i < 4 * 256; i += NWAVES * 64) { const int h = i / 256, idx = i % 256; bb[i] = t5[t5_bucket_dev(idx - 191) * 4 + h] * LOG2E; }
    __syncthreads();
}

template <int MIX>
__device__ __forceinline__ void attn_unit(Frame& F, int l, int n) {
    constexpr int T0 = MIX ? 8 : 2, NKV = MIX ? 4 : 2, NCH = 8 * NKV, LC = 64 * T0, RP = NKV * 64;
    constexpr int QC = MIX ? C_QC : C_QB, KC = MIX ? C_KC : C_KB, VC = MIX ? C_VC : C_VB, OC = MIX ? 768 : 512;
    constexpr float C2 = 0.125f * LOG2E;
    const bf16* proj = (const bf16*)(F.ws + WS_PROJ); bf16* mixed = (bf16*)(F.ws + WS_MIXED);
    const int tid = F.tid, lane = F.lane, wave = F.wave, head = wave >> 1, qh = wave & 1, kvh = MIX ? head : (head >> 1), r32 = lane & 31, hi = lane >> 5;
    const bool isp = n < 256; const int b = n - 256; const int row0 = isp ? 64 * n : NTP + 64 * b;
    bf16x8v qf[4];
    { const bf16* qp = proj + (size_t)(row0 + 32 * qh + r32) * PLD + QC + 64 * head + 8 * hi;
#pragma unroll
      for (int d0 = 0; d0 < 4; ++d0) qf[d0] = *(const bf16x8v*)(qp + 16 * d0); }
    float m_run, l_run; f32x16 o0, o1;
#pragma unroll
    for (int r = 0; r < 16; ++r) { o0[r] = 0.f; o1[r] = 0.f; }
    if (MIX) { m_run = -1e30f; l_run = 0.f; } else { m_run = INP(IN_SINK)[l * 4 + head] * LOG2E; l_run = (hi == 0) ? 1.f : 0.f; }
    LAS float* wsf = (LAS float*)(F.lds + AT_WS) + wave * 64;
    const LAS float* BT = (const LAS float*)(F.lds + (MIX ? AT_BTC : AT_BTB)) + head * (MIX ? 640 : 256);
    const LAS unsigned char* Kb = F.lds + AT_K + kvh * 9216 + r32 * 144 + hi * 16;
    const LAS unsigned char* Vb = F.lds + AT_V + kvh * 12288 + (4 * hi + ((lane & 15) >> 2)) * 192 + ((lane >> 4) & 1) * 32 + (lane & 3) * 8;
    const float* cki = (MIX ? INP(IN_CCK) : INP(IN_CBK)) + ((size_t)l * 32 + (isp ? 0 : b)) * LC * RP;
    const float* cvi = (MIX ? INP(IN_CCV) : INP(IN_CBV)) + ((size_t)l * 32 + (isp ? 0 : b)) * LC * RP;
    float* oko = F.out + (isp ? (MIX ? O_KCP : O_KBP) + (size_t)l * LC * RP : (MIX ? O_KCS : O_KBS) + ((size_t)l * 32 + b) * LC * RP);
    float* ovo = F.out + (isp ? (MIX ? O_VCP : O_VBP) + (size_t)l * LC * RP : (MIX ? O_VCS : O_VBS) + ((size_t)l * 32 + b) * LC * RP);

#define ATT_COMPUTE(t_) do { \
        f32x16 p0, p1; \
        _Pragma("unroll") for (int r = 0; r < 16; ++r) { p0[r] = 0.f; p1[r] = 0.f; } \
        _Pragma("unroll") for (int d0 = 0; d0 < 4; ++d0) { \
            const bf16x8v kf0 = *(const LAS bf16x8v*)(Kb + d0 * 32), kf1 = *(const LAS bf16x8v*)(Kb + 32 * 144 + d0 * 32); \
            p0 = __builtin_amdgcn_mfma_f32_32x32x16_bf16(kf0, qf[d0], p0, 0, 0, 0); p1 = __builtin_amdgcn_mfma_f32_32x32x16_bf16(kf1, qf[d0], p1, 0, 0, 0); } \
        const int bi = 64 * (t_) + 63 - (32 * qh + r32) + 4 * hi; float tmax = -1e30f; \
        _Pragma("unroll") for (int r = 0; r < 16; ++r) { const int k = (r & 3) + 8 * (r >> 2); \
            p0[r] = p0[r] * C2 + BT[bi + k]; p1[r] = p1[r] * C2 + BT[bi + k + 32]; tmax = fmaxf(tmax, fmaxf(p0[r], p1[r])); } \
        tmax = fmaxf(tmax, __shfl_xor(tmax, 32)); \
        const float mnew = fmaxf(m_run, tmax), alpha = __builtin_amdgcn_exp2f(m_run - mnew); m_run = mnew; \
        float ps = 0.f; \
        _Pragma("unroll") for (int r = 0; r < 16; ++r) { p0[r] = __builtin_amdgcn_exp2f(p0[r] - mnew); p1[r] = __builtin_amdgcn_exp2f(p1[r] - mnew); ps += p0[r] + p1[r]; } \
        l_run = l_run * alpha + ps; \
        if (!__all(alpha == 1.0f)) { if (hi == 0) wsf[r32] = alpha; \
            _Pragma("unroll") for (int r = 0; r < 16; ++r) { const float a = wsf[crow16(r, hi)]; o0[r] *= a; o1[r] *= a; } } \
        bf16x8v pa[4]; \
        { v4u w; w.x = cvtpk(p0[0], p0[1]); w.y = cvtpk(p0[2], p0[3]); w.z = cvtpk(p0[4], p0[5]); w.w = cvtpk(p0[6], p0[7]); pa[0] = __builtin_bit_cast(bf16x8v, w); \
          w.x = cvtpk(p0[8], p0[9]); w.y = cvtpk(p0[10], p0[11]); w.z = cvtpk(p0[12], p0[13]); w.w = cvtpk(p0[14], p0[15]); pa[1] = __builtin_bit_cast(bf16x8v, w); \
          w.x = cvtpk(p1[0], p1[1]); w.y = cvtpk(p1[2], p1[3]); w.z = cvtpk(p1[4], p1[5]); w.w = cvtpk(p1[6], p1[7]); pa[2] = __builtin_bit_cast(bf16x8v, w); \
          w.x = cvtpk(p1[8], p1[9]); w.y = cvtpk(p1[10], p1[11]); w.z = cvtpk(p1[12], p1[13]); w.w = cvtpk(p1[14], p1[15]); pa[3] = __builtin_bit_cast(bf16x8v, w); } \
        _Pragma("unroll") for (int ks = 0; ks < 4; ++ks) { \
            const s16x4v a0 = ds_tr16(Vb + ks * 16 * 192), a1 = ds_tr16(Vb + ks * 16 * 192 + 8 * 192), c0 = ds_tr16(Vb + ks * 16 * 192 + 64), c1 = ds_tr16(Vb + ks * 16 * 192 + 8 * 192 + 64); \
            const bf16x8v v0 = (bf16x8v){a0[0], a0[1], a0[2], a0[3], a1[0], a1[1], a1[2], a1[3]}, v1 = (bf16x8v){c0[0], c0[1], c0[2], c0[3], c1[0], c1[1], c1[2], c1[3]}; \
            o0 = __builtin_amdgcn_mfma_f32_32x32x16_bf16(pa[ks], v0, o0, 0, 0, 0); o1 = __builtin_amdgcn_mfma_f32_32x32x16_bf16(pa[ks], v1, o1, 0, 0, 0); } \
    } while (0)

    if (!isp) {
        f32x4 kr[2 * NKV], vr[2 * NKV];
#define ATT_LOADF(t_) do { _Pragma("unroll") for (int i = 0; i < NKV; ++i) { const int ci = tid + 512 * i, row = ci / NCH, cc = ci % NCH; \
            const float* kp = cki + (size_t)(64 * (t_) + row) * RP + cc * 8; const float* vp = cvi + (size_t)(64 * (t_) + row) * RP + cc * 8; \
            kr[2 * i] = *(const f32x4*)kp; kr[2 * i + 1] = *(const f32x4*)(kp + 4); vr[2 * i] = *(const f32x4*)vp; vr[2 * i + 1] = *(const f32x4*)(vp + 4); } } while (0)
        for (int t = 0; t < T0; ++t) {
            __syncthreads();
            ATT_LOADF(t);
#pragma unroll
            for (int i = 0; i < NKV; ++i) { const int ci = tid + 512 * i, row = ci / NCH, cc = ci % NCH, hd = cc >> 3, c8 = cc & 7;
                v4u kw, vw; kw.x = pk2(kr[2 * i][0], kr[2 * i][1]); kw.y = pk2(kr[2 * i][2], kr[2 * i][3]); kw.z = pk2(kr[2 * i + 1][0], kr[2 * i + 1][1]); kw.w = pk2(kr[2 * i + 1][2], kr[2 * i + 1][3]);
                vw.x = pk2(vr[2 * i][0], vr[2 * i][1]); vw.y = pk2(vr[2 * i][2], vr[2 * i][3]); vw.z = pk2(vr[2 * i + 1][0], vr[2 * i + 1][1]); vw.w = pk2(vr[2 * i + 1][2], vr[2 * i + 1][3]);
                *(LAS v4u*)(F.lds + AT_K + hd * 9216 + row * 144 + c8 * 16) = kw; *(LAS v4u*)(F.lds + AT_V + hd * 12288 + row * 192 + c8 * 16) = vw;
                if (t >= 1) { float* ok = oko + (size_t)(64 * (t - 1) + row) * RP + cc * 8; float* ov = ovo + (size_t)(64 * (t - 1) + row) * RP + cc * 8;
                    *(f32x4*)ok = kr[2 * i]; *(f32x4*)(ok + 4) = kr[2 * i + 1]; *(f32x4*)ov = vr[2 * i]; *(f32x4*)(ov + 4) = vr[2 * i + 1]; } }
            __syncthreads();
            ATT_COMPUTE(t);
        }
#undef ATT_LOADF
    }
    {
        const int tb = isp ? (T0 - n > 0 ? T0 - n : 0) : T0;
        v4u kr[NKV], vr[NKV];
#define ATT_LOADB(t_) do { const int srow = isp ? 64 * (n - T0 + (t_)) : row0; \
        _Pragma("unroll") for (int i = 0; i < NKV; ++i) { const int ci = tid + 512 * i, row = ci / NCH, cc = ci % NCH; \
            kr[i] = *(const v4u*)(proj + (size_t)(srow + row) * PLD + KC + cc * 8); vr[i] = *(const v4u*)(proj + (size_t)(srow + row) * PLD + VC + cc * 8); } } while (0)
        const bool wr_out = isp ? (n >= 256 - T0) : true; const int orow0 = isp ? 64 * (n - (256 - T0)) : 64 * (T0 - 1);
        for (int t = tb; t <= T0; ++t) {
            __syncthreads();
            ATT_LOADB(t);
#pragma unroll
            for (int i = 0; i < NKV; ++i) { const int ci = tid + 512 * i, row = ci / NCH, cc = ci % NCH, hd = cc >> 3, c8 = cc & 7;
                *(LAS v4u*)(F.lds + AT_K + hd * 9216 + row * 144 + c8 * 16) = kr[i]; *(LAS v4u*)(F.lds + AT_V + hd * 12288 + row * 192 + c8 * 16) = vr[i];
                if (t == T0 && wr_out) { float* ok = oko + (size_t)(orow0 + row) * RP + cc * 8; float* ov = ovo + (size_t)(orow0 + row) * RP + cc * 8;
                    *(f32x4*)ok = (f32x4){bflo(kr[i].x), bfhi(kr[i].x), bflo(kr[i].y), bfhi(kr[i].y)}; *(f32x4*)(ok + 4) = (f32x4){bflo(kr[i].z), bfhi(kr[i].z), bflo(kr[i].w), bfhi(kr[i].w)};
                    *(f32x4*)ov = (f32x4){bflo(vr[i].x), bfhi(vr[i].x), bflo(vr[i].y), bfhi(vr[i].y)}; *(f32x4*)(ov + 4) = (f32x4){bflo(vr[i].z), bfhi(vr[i].z), bflo(vr[i].w), bfhi(vr[i].w)}; } }
            __syncthreads();
            ATT_COMPUTE(t);
        }
#undef ATT_LOADB
    }
#undef ATT_COMPUTE
    { const float lt = l_run + __shfl_xor(l_run, 32); if (hi == 0) wsf[r32] = 1.0f / lt; }
    __syncthreads();
    { LAS bf16* stg = (LAS bf16*)(F.lds + AT_K) + wave * 2048;
#pragma unroll
      for (int r = 0; r < 16; ++r) { const int q = crow16(r, hi); const float a = wsf[q];
          stg[q * 64 + r32] = (bf16)f2bf(o0[r] * a); stg[q * 64 + 32 + r32] = (bf16)f2bf(o1[r] * a); }
      LDS_WAIT();
#pragma unroll
      for (int i = 0; i < 4; ++i) { const int row = i * 8 + (lane >> 3), ch = lane & 7; const v4u v = *(const LAS v4u*)(stg + row * 64 + ch * 8);
          *(v4u*)(mixed + (size_t)(row0 + 32 * qh + row) * DM + OC + 64 * head + ch * 8) = v; } }
}
__device__ __forceinline__ void attn_phase_fast(Frame& F, int l) {
    attn_build_tables(F, l);
    gu32* head = F.ctl + CW_Q + 64 * (2 * l);
    volatile LAS unsigned* qw = (volatile LAS unsigned*)(F.lds + AT_QW);
    for (;;) {
        if (F.tid == 0) qw[0] = __hip_atomic_fetch_add(head, 1u, RLX_AGENT);
        __syncthreads();
        const unsigned u = qw[0];
        __syncthreads();
        if (u >= 576u) break;
        if (u < 32u) attn_unit<1>(F, l, 256 + (int)u);
        else if (u < 288u) attn_unit<1>(F, l, (int)u - 32);
        else if (u < 320u) attn_unit<0>(F, l, 256 + (int)u - 288);
        else attn_unit<0>(F, l, (int)u - 320);
    }
}

#ifndef FAST_ATTN
#define FAST_ATTN 1
#endif
#ifndef FAST_GLA
#define FAST_GLA 0
#endif
#ifndef PHMASK
#define PHMASK 1023
#endif
#ifndef MK_ONE_LAUNCH
#define MK_ONE_LAUNCH 1
#endif
constexpr int PH_P0 = 0, PH_P1 = 1, PH_L0 = 2, PH_PER_LAYER = 7, PH_FINAL = PH_L0 + DEPTH * PH_PER_LAYER, N_PHASES = PH_FINAL + 1;

__global__ void __launch_bounds__(NWAVES * 64, 2) enc_fwd(Args args) {
    extern __shared__ __attribute__((aligned(16))) unsigned char lds[];
    Frame F;
    F.lds = (LAS unsigned char*)lds;
    F.MISC = (volatile LAS unsigned*)(F.lds + MISC_OFF);
    F.tid = threadIdx.x; F.lane = F.tid & 63; F.wave = __builtin_amdgcn_readfirstlane(F.tid >> 6);
    F.G = gridDim.x; { const int bx = blockIdx.x; F.vcu = (F.G % 8 == 0) ? (bx % 8) * (F.G / 8) + bx / 8 : bx; }
    F.out = args.out; F.ws = args.ws; F.ctl = (gu32*)(args.ws + WS_CTL);
    for (int u = F.tid; u < (LDS_BYTES - LDSCTL_OFF) / 4; u += NWAVES * 64) ((LAS unsigned*)(F.lds + LDSCTL_OFF))[u] = 0u;
    __syncthreads();
    if (F.tid == 0) { LAS unsigned long long* t = (LAS unsigned long long*)(F.lds + TBL_OFF);
#pragma unroll
        for (int i = 0; i < 24; ++i) t[i] = (unsigned long long)args.in[i]; }
    __syncthreads();
#if MK_ONE_LAUNCH
    XcdBarrier bar = xcd_barrier_post((unsigned*)(F.ctl + CW_BAR), F.MISC + 8);
#define GRID_BAR() xcd_barrier(bar)
#else
#define GRID_BAR() do {} while (0)
#endif
    const int lo = args.ph_lo, hi = args.ph_hi;
#define IN(k) (lo <= (k) && (k) < hi)
#define SEAM(k) do { if (IN(k) && IN((k) + 1)) GRID_BAR(); } while (0)
    const int gw = F.vcu * NWAVES + F.wave, NGW = F.G * NWAVES;

    if (IN(PH_P0) && (PHMASK & 1)) {
        for (int it = blockIdx.x; it < DEPTH * (NMOD / 64); it += F.G) skinny_item<0>(F, it / (NMOD / 64), it % (NMOD / 64));
        p0_transposes(F);
    }
    SEAM(PH_P0);
    if (IN(PH_P1) && (PHMASK & 2)) {
        constexpr int NB1 = NINP / 64, NB2 = DFF / 64;
        for (int it = blockIdx.x; it < DEPTH * (NB1 + NB2); it += F.G) { const int l = it / (NB1 + NB2), r = it % (NB1 + NB2);
            if (r < NB1) skinny_item<1>(F, l, r); else skinny_item<2>(F, l, r - NB1); }
        for (int m = gw; m < MTOK; m += NGW) xn0_row(F, m);
    }
    SEAM(PH_P1);
    float* MOD = (float*)(F.ws + WS_MOD);
    { constexpr int l = 0;
        const int pb = PH_L0 + l * PH_PER_LAYER;
        float* modl = MOD + (size_t)l * NSEQ * NMOD;
        if (IN(pb + 0) && (PHMASK & 4)) {
            pg8::Gemm g{(const bf16*)(F.ws + WS_XN), (const bf16*)(F.ws + WS_WIN) + (size_t)l * NINP * DM, MTOK, NINP, DM}; pg8::StaticOrder S; S.init(MTOK, NINP, F.G, (int)blockIdx.x);
            pg8::EpiProj E{(bf16*)(F.ws + WS_PROJ), (float*)(F.ws + WS_RA), (const float*)(F.ws + WS_ROWSQ), (const float*)(F.ws + WS_BIASM) + (size_t)l * NSEQ * NINP};
            pg8::gemm_phase<pg8::EpiProj, pg8::StaticOrder, true, true>(F.lds + RING_OFF, g, S, E);
        }
        SEAM(pb + 0);
        if (IN(pb + 1) && (PHMASK & 8)) {
#if FAST_ATTN
            attn_phase_fast(F, l);
#else
            attn_simple<1>(F, l); attn_simple<0>(F, l); cache_out_simple(F, l);
#endif
        }
        SEAM(pb + 1);
        if (IN(pb + 2) && (PHMASK & 16)) { gla_simple(F, l); }
        SEAM(pb + 2);
        if (IN(pb + 3) && (PHMASK & 32)) { gla_norm_simple(F, l); }
        SEAM(pb + 3);
        if (IN(pb + 4) && (PHMASK & 64)) {
            pg8::Gemm g{(const bf16*)(F.ws + WS_MIXED), (const bf16*)(F.ws + WS_WOUT) + (size_t)l * DM * DM, MTOK, DM, DM}; pg8::StaticOrder S; S.init(MTOK, DM, F.G, (int)blockIdx.x);
            pg8::EpiRes E{l == 0 ? INP(IN_XP) : F.out, l == 0 ? INP(IN_XS) : F.out + (size_t)NTP * DM, F.out, modl + 2048,
                          INP(IN_GMLP) + (size_t)l * DM, modl + 4096, (bf16*)(F.ws + WS_XN), (float*)(F.ws + WS_ROWSQ)};
            pg8::gemm_phase<pg8::EpiRes, pg8::StaticOrder, true, true>(F.lds + RING_OFF, g, S, E);
        }
        SEAM(pb + 4);
        if (IN(pb + 5) && (PHMASK & 128)) {
            pg8::Gemm g{(const bf16*)(F.ws + WS_XN), (const bf16*)(F.ws + WS_WUP) + (size_t)l * DFF * DM, MTOK, DFF, DM}; pg8::StaticOrder S; S.init(MTOK, DFF, F.G, (int)blockIdx.x);
            pg8::EpiUp E{(bf16*)(F.ws + WS_H), (const float*)(F.ws + WS_ROWSQ), (const float*)(F.ws + WS_BIASF) + (size_t)l * NSEQ * DFF};
            pg8::gemm_phase<pg8::EpiUp, pg8::StaticOrder, true, true>(F.lds + RING_OFF, g, S, E);
        }
        SEAM(pb + 5);
        if (IN(pb + 6) && (PHMASK & 256)) {
            pg8::Gemm g{(const bf16*)(F.ws + WS_H), (const bf16*)(F.ws + WS_WDN) + (size_t)l * DM * DFF, MTOK, DM, DFF}; pg8::StaticOrder S; S.init(MTOK, DM, F.G, (int)blockIdx.x);
            const bool more = (l + 1 < DEPTH);
            pg8::EpiRes E{F.out, F.out + (size_t)NTP * DM, F.out, modl + 5120,
                          more ? INP(IN_GMIX) + (size_t)(l + 1) * DM : nullptr, MOD + (size_t)(l + 1 < DEPTH ? l + 1 : l) * NSEQ * NMOD + 1024, (bf16*)(F.ws + WS_XN), (float*)(F.ws + WS_ROWSQ)};
            pg8::gemm_phase<pg8::EpiRes, pg8::StaticOrder, true, true>(F.lds + RING_OFF, g, S, E);
        }
        SEAM(pb + 6);
        }
    { constexpr int l = 1;
        const int pb = PH_L0 + l * PH_PER_LAYER;
        float* modl = MOD + (size_t)l * NSEQ * NMOD;
        if (IN(pb + 0) && (PHMASK & 4)) {
            pg8::Gemm g{(const bf16*)(F.ws + WS_XN), (const bf16*)(F.ws + WS_WIN) + (size_t)l * NINP * DM, MTOK, NINP, DM}; pg8::StaticOrder S; S.init(MTOK, NINP, F.G, (int)blockIdx.x);
            pg8::EpiProj E{(bf16*)(F.ws + WS_PROJ), (float*)(F.ws + WS_RA), (const float*)(F.ws + WS_ROWSQ), (const float*)(F.ws + WS_BIASM) + (size_t)l * NSEQ * NINP};
            pg8::gemm_phase<pg8::EpiProj, pg8::StaticOrder, true, true>(F.lds + RING_OFF, g, S, E);
        }
        SEAM(pb + 0);
        if (IN(pb + 1) && (PHMASK & 8)) {
#if FAST_ATTN
            attn_phase_fast(F, l);
#else
            attn_simple<1>(F, l); attn_simple<0>(F, l); cache_out_simple(F, l);
#endif
        }
        SEAM(pb + 1);
        if (IN(pb + 2) && (PHMASK & 16)) { gla_simple(F, l); }
        SEAM(pb + 2);
        if (IN(pb + 3) && (PHMASK & 32)) { gla_norm_simple(F, l); }
        SEAM(pb + 3);
        if (IN(pb + 4) && (PHMASK & 64)) {
            pg8::Gemm g{(const bf16*)(F.ws + WS_MIXED), (const bf16*)(F.ws + WS_WOUT) + (size_t)l * DM * DM, MTOK, DM, DM}; pg8::StaticOrder S; S.init(MTOK, DM, F.G, (int)blockIdx.x);
            pg8::EpiRes E{l == 0 ? INP(IN_XP) : F.out, l == 0 ? INP(IN_XS) : F.out + (size_t)NTP * DM, F.out, modl + 2048,
                          INP(IN_GMLP) + (size_t)l * DM, modl + 4096, (bf16*)(F.ws + WS_XN), (float*)(F.ws + WS_ROWSQ)};
            pg8::gemm_phase<pg8::EpiRes, pg8::StaticOrder, true, true>(F.lds + RING_OFF, g, S, E);
        }
        SEAM(pb + 4);
        if (IN(pb + 5) && (PHMASK & 128)) {
            pg8::Gemm g{(const bf16*)(F.ws + WS_XN), (const bf16*)(F.ws + WS_WUP) + (size_t)l * DFF * DM, MTOK, DFF, DM}; pg8::StaticOrder S; S.init(MTOK, DFF, F.G, (int)blockIdx.x);
            pg8::EpiUp E{(bf16*)(F.ws + WS_H), (const float*)(F.ws + WS_ROWSQ), (const float*)(F.ws + WS_BIASF) + (size_t)l * NSEQ * DFF};
            pg8::gemm_phase<pg8::EpiUp, pg8::StaticOrder, true, true>(F.lds + RING_OFF, g, S, E);
        }
        SEAM(pb + 5);
        if (IN(pb + 6) && (PHMASK & 256)) {
            pg8::Gemm g{(const bf16*)(F.ws + WS_H), (const bf16*)(F.ws + WS_WDN) + (size_t)l * DM * DFF, MTOK, DM, DFF}; pg8::StaticOrder S; S.init(MTOK, DM, F.G, (int)blockIdx.x);
            const bool more = (l + 1 < DEPTH);
            pg8::EpiRes E{F.out, F.out + (size_t)NTP * DM, F.out, modl + 5120,
                          more ? INP(IN_GMIX) + (size_t)(l + 1) * DM : nullptr, MOD + (size_t)(l + 1 < DEPTH ? l + 1 : l) * NSEQ * NMOD + 1024, (bf16*)(F.ws + WS_XN), (float*)(F.ws + WS_ROWSQ)};
            pg8::gemm_phase<pg8::EpiRes, pg8::StaticOrder, true, true>(F.lds + RING_OFF, g, S, E);
        }
        SEAM(pb + 6);
        }
    if (IN(PH_FINAL) && (PHMASK & 512)) { for (int m = gw; m < MTOK; m += NGW) final_row(F, m); }
#undef IN
#undef SEAM
}

extern "C" void kernel_launch(void* const* d_in, const int* in_sizes, int n_in, void* d_out, int out_size, void* d_ws, size_t ws_size, hipStream_t stream) {
    static int grid = 0;
    if (grid == 0) {
        if (n_in != 24 || out_size != (int)O_END || ws_size < WS_END) { fprintf(stderr, "kernel_launch: unexpected shapes: n_in %d out %d ws %zu\n", n_in, out_size, ws_size); grid = -1; return; }
        int dev = 0, cus = 0, per_cu = 0;
        if (hipGetDevice(&dev) != hipSuccess || hipDeviceGetAttribute(&cus, hipDeviceAttributeMultiprocessorCount, dev) != hipSuccess) { grid = -1; return; }
        if (hipFuncSetAttribute((const void*)enc_fwd, hipFuncAttributeMaxDynamicSharedMemorySize, LDS_BYTES) != hipSuccess) { fprintf(stderr, "kernel_launch: hipFuncSetAttribute failed\n"); grid = -1; return; }
        if (hipOccupancyMaxActiveBlocksPerMultiprocessor(&per_cu, (const void*)enc_fwd, NWAVES * 64, LDS_BYTES) != hipSuccess || per_cu < 1) { fprintf(stderr, "kernel_launch: occupancy query says %d\n", per_cu); (void)hipGetLastError(); per_cu = 1; }
        grid = cus;
    }
    if (grid < 0) return;
    (void)hipMemsetAsync((char*)d_ws + WS_CTL, 0, CTL_ZERO_BYTES, stream);
    Args a{};
    for (int i = 0; i < 24; ++i) a.in[i] = (const float*)d_in[i];
    a.out = (float*)d_out; a.ws = (unsigned char*)d_ws;
#if MK_ONE_LAUNCH
    a.ph_lo = 0; a.ph_hi = N_PHASES;
    hipLaunchKernelGGL(enc_fwd, dim3(grid), dim3(NWAVES * 64), LDS_BYTES, stream, a);
#else
    for (int p = 0; p < N_PHASES; ++p) { a.ph_lo = p; a.ph_hi = p + 1; hipLaunchKernelGGL(enc_fwd, dim3(grid), dim3(NWAVES * 64), LDS_BYTES, stream, a); }
#endif
}
```

```cpp
#include <hip/hip_runtime.h>
#include <cstdio>
#include <cstdint>
namespace pg8 {
#define PG8_LAS __attribute__((address_space(3)))
typedef unsigned short bf16_t;
typedef short bf16x8 __attribute__((ext_vector_type(8)));
typedef float f32x4 __attribute__((ext_vector_type(4)));
typedef unsigned u32x4 __attribute__((ext_vector_type(4)));
typedef unsigned u32x2 __attribute__((ext_vector_type(2)));
constexpr int BM = 256, BK = 64, HALF = 128, HTB = HALF * BK * 2  , STAGE_BYTES = 8 * HTB, NXCD = 8, WGM = 8;

__host__ __device__ __forceinline__ int lds_byte(int r, int c) { const int st = (r >> 4) * 2 + (c >> 5), rr = r & 15, cc = c & 31, ob = rr * 64 + cc * 2; return st * 1024 + (ob ^ (((ob >> 9) & 1) << 5)); }
__host__ __device__ __forceinline__ void stage_rc(int b, int& R, int& C) { const int st = b / 1024, sb = b % 1024, swz = sb ^ (((sb >> 9) & 1) << 5); R = (st >> 1) * 16 + swz / 64; C = (st & 1) * 32 + (swz % 64) / 2; }
__host__ __device__ __forceinline__ int perm32(int rho) { const int n = rho >> 4, i = rho & 15; return 8 * (i >> 2) + 4 * n + (i & 3); }

struct Unit { int pm, pn; };
struct Gemm { const bf16_t* A; const bf16_t* Bt; int M, N, K; };

struct StaticOrder {
    int nM, nN, nwg, G, c;
    __host__ __device__ void init(int M, int N, int G_, int c_) { nM = M / BM; nN = N / BM; nwg = nM * nN; G = G_; c = c_; }
    __host__ __device__ bool next(int i, Unit& u) const {
        const long L = (long)i * G + c; if (L >= nwg) return false;
        int wgid = (int)L; { const int q = nwg / NXCD, r = nwg % NXCD, xcd = wgid % NXCD, off = wgid / NXCD; wgid = (xcd < r ? xcd * (q + 1) : r * (q + 1) + (xcd - r) * q) + off; }
        const int nig = WGM * nN, gid = wgid / nig, fm = gid * WGM, gsz = (nM - fm) < WGM ? (nM - fm) : WGM;
        u.pm = fm + ((wgid % nig) % gsz); u.pn = (wgid % nig) / gsz; return true;
    }
    __device__ __forceinline__ void a_ready(const Unit&) const {}
    __device__ __forceinline__ void done(const Unit&) const {}
};

__device__ __forceinline__ unsigned cvt_pk_bf16(float lo, float hi) { unsigned r; asm volatile("v_cvt_pk_bf16_f32 %0, %1, %2" : "=v"(r) : "v"(lo), "v"(hi)); return r; }

constexpr int NTOK_P = 16384, D_MODEL = 1024, PLD = 2816, NMOD = 6144, NIN_PAD = 3072, DFF = 4096;
constexpr float NEPS = 1e-6f;
__device__ __forceinline__ int seq_of_row(int r) { return r < NTOK_P ? 0 : 1 + ((r - NTOK_P) >> 6); }
__device__ __forceinline__ float rstd_of(const float* rsq) {
    const f32x4 a = *(const f32x4*)rsq, b = *(const f32x4*)(rsq + 4), c = *(const f32x4*)(rsq + 8), d = *(const f32x4*)(rsq + 12);
    const float s = ((a[0] + a[1]) + (a[2] + a[3])) + ((b[0] + b[1]) + (b[2] + b[3])) + ((c[0] + c[1]) + (c[2] + c[3])) + ((d[0] + d[1]) + (d[2] + d[3]));
    return 1.0f / sqrtf(s * (1.0f / D_MODEL) + NEPS);
}


struct EpiProj {
    static constexpr bool PERM = true, AFTER_DRAIN = false;
    bf16_t* proj; float* ra; const float* rowsq; const float* bias;
    __device__ __forceinline__ void operator()(const f32x4 (&acc)[2][2][4][2], const Unit& u, int wr, int wc, int fr, int fq) const {
#pragma unroll
        for (int ai = 0; ai < 2; ++ai) {
            const int rowb = u.pm * BM + ai * HALF + wr * 64; const int s = seq_of_row(rowb);
            const int colt = u.pn * BM + wc * 32 + 8 * fq;
            const float* bs = bias + (size_t)s * NIN_PAD + colt;
            f32x4 bv[2][2];
#pragma unroll
            for (int bj = 0; bj < 2; ++bj)
#pragma unroll
                for (int n = 0; n < 2; ++n) bv[bj][n] = *(const f32x4*)(bs + bj * HALF + 4 * n);
#pragma unroll
            for (int m = 0; m < 4; ++m) { const int r = rowb + m * 16 + fr; const float rs = rstd_of(rowsq + (size_t)r * 16);
#pragma unroll
                for (int bj = 0; bj < 2; ++bj) { const f32x4 v0 = acc[ai][bj][m][0] * rs + bv[bj][0], v1 = acc[ai][bj][m][1] * rs + bv[bj][1];
                    if (u.pn < 11) { u32x4 w; w.x = cvt_pk_bf16(v0[0], v0[1]); w.y = cvt_pk_bf16(v0[2], v0[3]); w.z = cvt_pk_bf16(v1[0], v1[1]); w.w = cvt_pk_bf16(v1[2], v1[3]);
                        *(u32x4*)(proj + (size_t)r * PLD + colt + bj * HALF) = w; }
                    else if (bj == 0 && wc == 0 && fq < 2) { *(f32x4*)(ra + (size_t)r * 16 + 8 * fq) = v0; *(f32x4*)(ra + (size_t)r * 16 + 8 * fq + 4) = v1; } } }
        }
    }
};
struct EpiUp {
    static constexpr bool PERM = true, AFTER_DRAIN = false;
    bf16_t* H; const float* rowsq; const float* bias;
    __device__ __forceinline__ void operator()(const f32x4 (&acc)[2][2][4][2], const Unit& u, int wr, int wc, int fr, int fq) const {
#pragma unroll
        for (int ai = 0; ai < 2; ++ai) {
            const int rowb = u.pm * BM + ai * HALF + wr * 64; const int s = seq_of_row(rowb);
            const int colt = u.pn * BM + wc * 32 + 8 * fq;
            const float* bs = bias + (size_t)s * DFF + colt;
            f32x4 bv[2][2];
#pragma unroll
            for (int bj = 0; bj < 2; ++bj)
#pragma unroll
                for (int n = 0; n < 2; ++n) bv[bj][n] = *(const f32x4*)(bs + bj * HALF + 4 * n);
#pragma unroll
            for (int m = 0; m < 4; ++m) { const int r = rowb + m * 16 + fr; const float rs = rstd_of(rowsq + (size_t)r * 16);
#pragma unroll
                for (int bj = 0; bj < 2; ++bj) { f32x4 v0 = acc[ai][bj][m][0] * rs + bv[bj][0], v1 = acc[ai][bj][m][1] * rs + bv[bj][1];
#pragma unroll
                    for (int e = 0; e < 4; ++e) { const float a = fmaxf(v0[e], 0.f), b = fmaxf(v1[e], 0.f); v0[e] = a * a; v1[e] = b * b; }
                    u32x4 w; w.x = cvt_pk_bf16(v0[0], v0[1]); w.y = cvt_pk_bf16(v0[2], v0[3]); w.z = cvt_pk_bf16(v1[0], v1[1]); w.w = cvt_pk_bf16(v1[2], v1[3]);
                    *(u32x4*)(H + (size_t)r * DFF + colt + bj * HALF) = w; } }
        }
    }
};
struct EpiRes {
    static constexpr bool PERM = false, AFTER_DRAIN = false;
    const float* basep; const float* bases; float* out; const float* gate;
    const float* gn; const float* scn; bf16_t* xn; float* rowsq;
    __device__ __forceinline__ void operator()(const f32x4 (&acc)[2][2][4][2], const Unit& u, int wr, int wc, int fr, int fq) const {
#pragma unroll
        for (int ai = 0; ai < 2; ++ai) {
            const int rowb = u.pm * BM + ai * HALF + wr * 64; const int s = seq_of_row(rowb);
            const int colt = u.pn * BM + wc * 32 + 4 * fq;
            f32x4 gv[2][2], wv[2][2];
#pragma unroll
            for (int bj = 0; bj < 2; ++bj)
#pragma unroll
                for (int n = 0; n < 2; ++n) { const int c = colt + bj * HALF + 16 * n; gv[bj][n] = *(const f32x4*)(gate + (size_t)s * NMOD + c);
                    if (gn) { const f32x4 g = *(const f32x4*)(gn + c), sc = *(const f32x4*)(scn + (size_t)s * NMOD + c); wv[bj][n] = g * (sc + 1.0f); } else wv[bj][n] = (f32x4){0.f, 0.f, 0.f, 0.f}; }
#pragma unroll
            for (int m = 0; m < 4; ++m) { const int r = rowb + m * 16 + fr;
                const float* bp = (r < NTOK_P) ? basep + (size_t)r * D_MODEL : bases + (size_t)(r - NTOK_P) * D_MODEL;
                float ss = 0.f;
#pragma unroll
                for (int bj = 0; bj < 2; ++bj)
#pragma unroll
                    for (int n = 0; n < 2; ++n) { const int c = colt + bj * HALF + 16 * n;
                        const f32x4 bsv = *(const f32x4*)(bp + c); const f32x4 x1 = bsv + gv[bj][n] * acc[ai][bj][m][n];
                        *(f32x4*)(out + (size_t)r * D_MODEL + c) = x1;
                        ss += (x1[0] * x1[0] + x1[1] * x1[1]) + (x1[2] * x1[2] + x1[3] * x1[3]);
                        if (gn) { const f32x4 y = x1 * wv[bj][n]; u32x2 w; w.x = cvt_pk_bf16(y[0], y[1]); w.y = cvt_pk_bf16(y[2], y[3]); *(u32x2*)(xn + (size_t)r * D_MODEL + c) = w; } }
                ss += __shfl_xor(ss, 16); ss += __shfl_xor(ss, 32);
                if (fq == 0) rowsq[(size_t)r * 16 + u.pn * 4 + wc] = ss;
            }
        }
    }
};
template <class Epi, class Sched, bool ALIGN_EPI = false, bool SP2 = false>
__device__ __forceinline__ void gemm_phase(PG8_LAS unsigned char* lds, const Gemm g, const Sched& S, const Epi& E) {
    const int tid = threadIdx.x, wid = __builtin_amdgcn_readfirstlane(tid >> 6), lane = tid & 63, wr = wid >> 2, wc = wid & 3, fr = lane & 15, fq = lane >> 4;
    const int K = g.K, nt = K / BK;
    unsigned voffA[2], voffB[2];
#pragma unroll
    for (int i = 0; i < 2; ++i) { int R, C; stage_rc(tid * 16 + i * 8192, R, C); const int Rb = Epi::PERM ? ((R & ~31) + perm32(R & 31)) : R;
        voffA[i] = (unsigned)(R * K + C) * 2u; voffB[i] = (unsigned)(Rb * K + C) * 2u; }
    const size_t kstep = (size_t)(BK * 2);
    const size_t hstep = (size_t)HALF * K * 2;
    const size_t tstep = 2 * hstep;
    const unsigned ldsw = (unsigned)wid * 1024u;
    const int aoff = lds_byte(wr * 64 + fr, fq * 8), boff = lds_byte(wc * 32 + fr, fq * 8);
#define PG8_SA(b, h) (((b) * 2 + (h)) * HTB)
#define PG8_SB(b, h) ((4 + (b) * 2 + (h)) * HTB)
#define PG8_STAGE(bufoff, gbase, voff) do { _Pragma("unroll") for (int _i = 0; _i < 2; ++_i) \
        __builtin_amdgcn_global_load_lds((const unsigned*)((const char*)(gbase) + (voff)[_i]), (PG8_LAS unsigned*)(lds + (bufoff) + ldsw + _i * 8192), 16, 0, 0); } while (0)
#define PG8_LDA(dst, b, h) do { _Pragma("unroll") for (int m = 0; m < 4; ++m) _Pragma("unroll") for (int k = 0; k < 2; ++k) dst[m][k] = *(const PG8_LAS bf16x8*)(lds + PG8_SA(b, h) + aoff + m * 2048 + k * 1024); } while (0)
#define PG8_LDB(dst, b, h) do { _Pragma("unroll") for (int n = 0; n < 2; ++n) _Pragma("unroll") for (int k = 0; k < 2; ++k) dst[n][k] = *(const PG8_LAS bf16x8*)(lds + PG8_SB(b, h) + boff + n * 2048 + k * 1024); } while (0)
#define PG8_MMA(ai, bj, At, Bt) do { __builtin_amdgcn_s_setprio(1); _Pragma("unroll") for (int m = 0; m < 4; ++m) _Pragma("unroll") for (int n = 0; n < 2; ++n) _Pragma("unroll") for (int k = 0; k < 2; ++k) \
        acc[ai][bj][m][n] = __builtin_amdgcn_mfma_f32_16x16x32_bf16(Bt[n][k], At[m][k], acc[ai][bj][m][n], 0, 0, 0); __builtin_amdgcn_s_setprio(0); } while (0)
#define PG8_WAIT_V(n) asm volatile("s_waitcnt vmcnt(" #n ")" ::: "memory")
#define PG8_WAIT_L(n) asm volatile("s_waitcnt lgkmcnt(" #n ")" ::: "memory")
#define PG8_BAR __builtin_amdgcn_s_barrier()
#define PG8_SCHED __builtin_amdgcn_sched_barrier(0)
    Unit cur, nxt; int ui = 0;
    if (!S.next(0, cur)) return;
    f32x4 acc[2][2][4][2];
#pragma unroll
    for (int a = 0; a < 2; ++a)
#pragma unroll
        for (int b = 0; b < 2; ++b)
#pragma unroll
            for (int m = 0; m < 4; ++m)
#pragma unroll
                for (int n = 0; n < 2; ++n) acc[a][b][m][n] = (f32x4){0.f, 0.f, 0.f, 0.f};
    bf16x8 At[4][2], B0[2][2], B1[2][2];
    const char* cA = (const char*)g.A + (size_t)cur.pm * tstep; const char* cB = (const char*)g.Bt + (size_t)cur.pn * tstep;
    S.a_ready(cur);
    if constexpr (SP2) {
        PG8_STAGE(PG8_SB(0, 0), cB, voffB); PG8_STAGE(PG8_SB(0, 1), cB + hstep, voffB); PG8_STAGE(PG8_SA(0, 0), cA, voffA); PG8_STAGE(PG8_SA(0, 1), cA + hstep, voffA);
        if (wr == 1) PG8_BAR;
        PG8_WAIT_V(2); PG8_BAR;
        PG8_STAGE(PG8_SB(1, 0), cB + kstep, voffB); PG8_STAGE(PG8_SA(1, 0), cA + kstep, voffA); PG8_STAGE(PG8_SB(1, 1), cB + hstep + kstep, voffB);
        PG8_WAIT_V(6); PG8_BAR;
    } else {
        PG8_STAGE(PG8_SB(0, 0), cB, voffB); PG8_STAGE(PG8_SA(0, 0), cA, voffA); PG8_STAGE(PG8_SB(0, 1), cB + hstep, voffB); PG8_STAGE(PG8_SA(0, 1), cA + hstep, voffA);
        if (wr == 1) PG8_BAR;
        PG8_WAIT_V(4); PG8_BAR;
        PG8_STAGE(PG8_SB(1, 0), cB + kstep, voffB); PG8_STAGE(PG8_SA(1, 0), cA + kstep, voffA); PG8_STAGE(PG8_SB(1, 1), cB + hstep + kstep, voffB);
        PG8_WAIT_V(6); PG8_BAR;
    }
    for (;;) {
        const bool has_next = S.next(ui + 1, nxt);
        const char* nA = has_next ? (const char*)g.A + (size_t)nxt.pm * tstep : cA; const char* nB = has_next ? (const char*)g.Bt + (size_t)nxt.pn * tstep : cB;
        for (int t = 0; t < nt; t += 2) {
            const bool last = (t == nt - 2);
            const char* a1 = cA + (size_t)(t + 1) * kstep;
            const char* a2 = last ? nA : cA + (size_t)(t + 2) * kstep; const char* b2 = last ? nB : cB + (size_t)(t + 2) * kstep;
            const char* a3 = a2 + kstep; const char* b3 = b2 + kstep;
            if (last && has_next) S.a_ready(nxt);
            if constexpr (SP2) {
            PG8_LDB(B0, 0, 0); PG8_LDB(B1, 0, 1); PG8_SCHED; PG8_LDA(At, 0, 0); PG8_STAGE(PG8_SA(1, 1), a1 + hstep, voffA);
            PG8_WAIT_V(8); PG8_WAIT_L(0); PG8_BAR; PG8_MMA(0, 0, At, B0); PG8_MMA(0, 1, At, B1); PG8_BAR; PG8_SCHED;
            PG8_LDA(At, 0, 1); PG8_STAGE(PG8_SB(0, 0), b2, voffB); PG8_STAGE(PG8_SB(0, 1), b2 + hstep, voffB); PG8_STAGE(PG8_SA(0, 0), a2, voffA);
            PG8_WAIT_V(8); PG8_WAIT_L(0); PG8_BAR; PG8_MMA(1, 0, At, B0); PG8_MMA(1, 1, At, B1); PG8_BAR; PG8_SCHED;
            PG8_LDB(B0, 1, 0); PG8_LDB(B1, 1, 1); PG8_SCHED; PG8_LDA(At, 1, 0); PG8_STAGE(PG8_SA(0, 1), a2 + hstep, voffA);
            PG8_WAIT_V(8); PG8_WAIT_L(0); PG8_BAR; PG8_MMA(0, 0, At, B0); PG8_MMA(0, 1, At, B1); PG8_BAR; PG8_SCHED;
            PG8_LDA(At, 1, 1); PG8_STAGE(PG8_SB(1, 0), b3, voffB); PG8_STAGE(PG8_SB(1, 1), b3 + hstep, voffB); PG8_STAGE(PG8_SA(1, 0), a3, voffA);
            PG8_WAIT_V(8); PG8_WAIT_L(0); PG8_BAR; PG8_MMA(1, 0, At, B0); PG8_MMA(1, 1, At, B1); PG8_BAR; PG8_SCHED;
            } else {
            PG8_LDB(B0, 0, 0); PG8_SCHED; PG8_LDA(At, 0, 0); PG8_STAGE(PG8_SA(1, 1), a1 + hstep, voffA);
            PG8_WAIT_L(8); PG8_BAR; PG8_WAIT_L(0); PG8_MMA(0, 0, At, B0); PG8_BAR; PG8_SCHED;
            PG8_LDB(B1, 0, 1); PG8_STAGE(PG8_SB(0, 0), b2, voffB);
            PG8_BAR; PG8_WAIT_L(0); PG8_MMA(0, 1, At, B1); PG8_BAR;
            PG8_LDA(At, 0, 1); PG8_STAGE(PG8_SA(0, 0), a2, voffA);
            PG8_BAR; PG8_WAIT_L(0); PG8_MMA(1, 0, At, B0); PG8_BAR; PG8_SCHED;
            PG8_STAGE(PG8_SB(0, 1), b2 + hstep, voffB);
            PG8_WAIT_V(6); PG8_BAR; PG8_MMA(1, 1, At, B1); PG8_BAR;
            PG8_LDB(B0, 1, 0); PG8_SCHED; PG8_LDA(At, 1, 0); PG8_STAGE(PG8_SA(0, 1), a2 + hstep, voffA);
            PG8_WAIT_L(8); PG8_BAR; PG8_WAIT_L(0); PG8_MMA(0, 0, At, B0); PG8_BAR; PG8_SCHED;
            PG8_LDB(B1, 1, 1); PG8_STAGE(PG8_SB(1, 0), b3, voffB);
            PG8_BAR; PG8_WAIT_L(0); PG8_MMA(0, 1, At, B1); PG8_BAR;
            PG8_LDA(At, 1, 1); PG8_STAGE(PG8_SA(1, 0), a3, voffA);
            PG8_BAR; PG8_WAIT_L(0); PG8_MMA(1, 0, At, B0); PG8_BAR; PG8_SCHED;
            PG8_STAGE(PG8_SB(1, 1), b3 + hstep, voffB);
            PG8_WAIT_V(6); PG8_BAR; PG8_MMA(1, 1, At, B1); PG8_BAR;
            }
        }
        if constexpr (ALIGN_EPI) { if (wr == 0) PG8_BAR; }
        if constexpr (!Epi::AFTER_DRAIN) { E(acc, cur, wr, wc, fr, fq); S.done(cur); }
        if (!has_next) break;
#pragma unroll
        for (int a = 0; a < 2; ++a)
#pragma unroll
            for (int b = 0; b < 2; ++b)
#pragma unroll
                for (int m = 0; m < 4; ++m)
#pragma unroll
                    for (int n = 0; n < 2; ++n) acc[a][b][m][n] = (f32x4){0.f, 0.f, 0.f, 0.f};
        cur = nxt; cA = nA; cB = nB; ++ui;
        if constexpr (ALIGN_EPI) { if (wr == 1) PG8_BAR; }
    }
    PG8_WAIT_V(0);
    if constexpr (!ALIGN_EPI) { if (wr == 0) PG8_BAR; }
    PG8_BAR;
    if constexpr (Epi::AFTER_DRAIN) { E.fused(acc, cur, wr, wc, fr, fq, lds, wid, lane); S.done(cur); }
#undef PG8_SA
#undef PG8_SB
#undef PG8_STAGE
#undef PG8_LDA
#undef PG8_LDB
#undef PG8_MMA
#undef PG8_WAIT_V
#undef PG8_WAIT_L
#undef PG8_BAR
#undef PG8_SCHED
}
}

constexpr int NWAVES = 8;
constexpr int DEPTH = 2, DM = 1024, NTP = 16384, NTS = 2048, MTOK = NTP + NTS, NSEQ = 33, NCHUNK = MTOK / 64;
constexpr int PLD = 2816, NINP = 3072, NIN_SRC = 2832, DFF = 4096, NMOD = 6144;
constexpr float EPS = 1e-6f;
constexpr int C_QA = 0, C_KA = 256, C_VA = 512, C_GA = 1024, C_QB = 1536, C_KB = 1792, C_VB = 1920, C_QC = 2048, C_KC = 2304, C_VC = 2560;
constexpr size_t O_Y = 0, O_SGP = 18874368, O_KBP = 18939904, O_VBP = 18972672, O_KCP = 19005440, O_VCP = 19267584, O_SGS = 19529728,
                 O_KBS = 21626880, O_VBS = 22675456, O_KCS = 23724032, O_VCS = 32112640, O_END = 40501248;
constexpr size_t MiB = 1u << 20;
constexpr size_t WS_CTL = 0, CTL_ZERO_BYTES = 1 * MiB;
constexpr size_t WS_MOD = 1 * MiB, WS_BIASM = 3 * MiB, WS_BIASF = 4 * MiB, WS_ROWSQ = 6 * MiB, WS_RA = 8 * MiB, WS_DN = 10 * MiB;
constexpr size_t WS_WIN = 12 * MiB, WS_WOUT = 24 * MiB, WS_WUP = 28 * MiB, WS_WDN = 44 * MiB;
constexpr size_t WS_XN = 60 * MiB;
constexpr size_t WS_PROJ = 96 * MiB;
constexpr size_t WS_MIXED = 195 * MiB;
constexpr size_t WS_SST = 231 * MiB;
constexpr size_t WS_H = 96 * MiB;
constexpr size_t WS_END = 249 * MiB;
constexpr int CW_TMO = 0, CW_CODE = 1, CW_BAR = 4096, CW_Q = 16384;
constexpr int RING_OFF = 0, RING_BYTES = 131072;
constexpr int LDSCTL_OFF = 160 * 1024 - 1024, MISC_OFF = LDSCTL_OFF + 320, TBL_OFF = LDSCTL_OFF + 512;
constexpr int LDS_BYTES = 160 * 1024;

#define GAS __attribute__((address_space(1)))
#define LAS __attribute__((address_space(3)))
typedef unsigned short bf16;
typedef unsigned v4u __attribute__((ext_vector_type(4)));
typedef unsigned v2u __attribute__((ext_vector_type(2)));
typedef float f32x4 __attribute__((ext_vector_type(4)));
typedef GAS unsigned gu32;
#define RLX_AGENT __ATOMIC_RELAXED, __HIP_MEMORY_SCOPE_AGENT
#define LDS_WAIT() asm volatile("s_waitcnt lgkmcnt(0)" ::: "memory")
#define VM_WAIT() asm volatile("s_waitcnt vmcnt(0)" ::: "memory")
__device__ __forceinline__ unsigned f2bf(float f) { unsigned u = __builtin_bit_cast(unsigned, f); return (u + 0x7fffu + ((u >> 16) & 1u)) >> 16; }
__device__ __forceinline__ unsigned pk2(float lo, float hi) { return f2bf(lo) | (f2bf(hi) << 16); }
__device__ __forceinline__ float bf2f(unsigned short h) { return __builtin_bit_cast(float, (unsigned)h << 16); }
__device__ __forceinline__ float bflo(unsigned w) { return __builtin_bit_cast(float, w << 16); }
__device__ __forceinline__ float bfhi(unsigned w) { return __builtin_bit_cast(float, w & 0xffff0000u); }
__device__ __forceinline__ float wave_sum(float v) {
#pragma unroll
    for (int o = 1; o < 64; o <<= 1) v += __shfl_xor(v, o);
    return v;
}
__device__ __forceinline__ float wave_max(float v) {
#pragma unroll
    for (int o = 1; o < 64; o <<= 1) v = fmaxf(v, __shfl_xor(v, o));
    return v;
}
__device__ __forceinline__ float silu_f(float x) { return x / (1.0f + __expf(-x)); }
__device__ __forceinline__ float logsigmoid_f(float x) { return fminf(x, 0.f) - log1pf(__expf(-fabsf(x))); }
#define XB_TMO      128
#define XB_XCNT(j)  (256  + 64 * (j))
#define XB_XSUB(j)  (1280 + 64 * (j))
#define XB_XGEN(j)  (2304 + 64 * (j))
#define XB_TOP      3328
#define XB_TOPGEN   3392
#define XCD_BAR_WORDS 3456
#define XB_SPIN_CAP (1u << 24)

__device__ __forceinline__ unsigned xb_ld(unsigned* p)              { return __hip_atomic_load(p, __ATOMIC_RELAXED, __HIP_MEMORY_SCOPE_AGENT); }
__device__ __forceinline__ unsigned xb_add(unsigned* p, unsigned v) { return __hip_atomic_fetch_add(p, v, __ATOMIC_RELAXED, __HIP_MEMORY_SCOPE_AGENT); }
__device__ __forceinline__ unsigned xb_xcc_id() { return (unsigned)__builtin_amdgcn_s_getreg((3 << 11) | 20) & 0xFu; }
#define XB_SPIN(cond, bar) do { unsigned _sp = 0; while (cond) { __builtin_amdgcn_s_sleep(1); \
    if ((++_sp & 255u) == 0u) { if (xb_ld(&(bar)[XB_TMO])) break; if (_sp > XB_SPIN_CAP) { atomicAdd(&(bar)[XB_TMO], 1u); break; } } } } while (0)

struct XcdBarrier {
    unsigned* bar; unsigned x;
    volatile LAS unsigned* st;
};

__device__ __forceinline__ XcdBarrier xcd_barrier_post(unsigned* bar, volatile LAS unsigned* st) {
    XcdBarrier b; b.bar = bar; b.x = xb_xcc_id(); b.st = st;
    if (threadIdx.x == 0) (void)xb_add(&bar[XB_XCNT(b.x)], 1u);
    return b;
}
__device__ __forceinline__ void xcd_barrier_complete(unsigned* bar, unsigned x, unsigned& nloc, unsigned& nx) {
    const unsigned G = gridDim.x * gridDim.y * gridDim.z;
    unsigned sum, cnt, mine, sp = 0u;
    for (;;) {
        sum = 0u; cnt = 0u; mine = 0u;
#pragma unroll
        for (unsigned j = 0; j < 16; ++j) { const unsigned c = xb_ld(&bar[XB_XCNT(j)]); sum += c; cnt += (c > 0u) ? 1u : 0u; mine = (j == x) ? c : mine; }
        if (sum == G) break;
        __builtin_amdgcn_s_sleep(1);
        if ((++sp & 255u) == 0u) { if (xb_ld(&bar[XB_TMO])) break; if (sp > XB_SPIN_CAP) { atomicAdd(&bar[XB_TMO], 1u); break; } }
    }
    nloc = mine > 0u ? mine : 1u; nx = cnt > 0u ? cnt : 1u;
}

__device__ __forceinline__ void xcd_barrier(const XcdBarrier& b) {
    asm volatile("s_waitcnt vmcnt(0)" ::: "memory");
    __syncthreads();
    if (threadIdx.x == 0) {
        unsigned* bar = b.bar;
        __builtin_amdgcn_s_waitcnt(0);
        unsigned nloc = b.st[0], nx = b.st[1];
        if (nloc == 0u) { xcd_barrier_complete(bar, b.x, nloc, nx); b.st[0] = nloc; b.st[1] = nx; }
        const unsigned old = xb_add(&bar[XB_XSUB(b.x)], 1u);
        const unsigned gen = old / nloc;
        if (old + 1u == (gen + 1u) * nloc) {
            __builtin_amdgcn_fence(__ATOMIC_RELEASE, "agent");
            asm volatile("s_waitcnt vmcnt(0)" ::: "memory");
            const unsigned og = xb_add(&bar[XB_TOP], 1u);
            const unsigned tg = og / nx;
            if (og + 1u == (tg + 1u) * nx) xb_add(&bar[XB_TOPGEN], 1u);
            else XB_SPIN(xb_ld(&bar[XB_TOPGEN]) == tg, bar);
            __builtin_amdgcn_fence(__ATOMIC_ACQUIRE, "agent");
            xb_add(&bar[XB_XGEN(b.x)], 1u);
            asm volatile("s_waitcnt vmcnt(0)" ::: "memory");
        } else {
            XB_SPIN(xb_ld(&bar[XB_XGEN(b.x)]) == gen, bar);
            __builtin_amdgcn_fence(__ATOMIC_ACQUIRE, "agent");
            asm volatile("s_waitcnt vmcnt(0)" ::: "memory");
        }
    }
    __syncthreads();
}

struct Args { const float* in[24]; float* out; unsigned char* ws; int ph_lo, ph_hi; };
static_assert(sizeof(Args) == 24 * 8 + 8 + 8 + 8, "Args has no padding");
__device__ __forceinline__ const float* inp_ptr(LAS unsigned char* lds, int i) {
    const unsigned long long v = ((const volatile LAS unsigned long long*)(lds + TBL_OFF))[i];
    const unsigned lo = __builtin_amdgcn_readfirstlane((unsigned)v), hi = __builtin_amdgcn_readfirstlane((unsigned)(v >> 32));
    return (const float*)(((unsigned long long)hi << 32) | lo);
}
#define INP(i) inp_ptr(F.lds, (i))
struct Frame {
    LAS unsigned char* lds;
    volatile LAS unsigned* MISC;
    gu32* ctl;
    int tid, lane, wave, vcu, G;
    float* out; unsigned char* ws;
};
#define IN_XP 0
#define IN_XS 1
#define IN_CP 2
#define IN_CS 3
#define IN_SG 4
#define IN_CBK 5
#define IN_CBV 6
#define IN_CCK 7
#define IN_CCV 8
#define IN_WADA 9
#define IN_BADA 10
#define IN_GMIX 11
#define IN_GMLP 12
#define IN_WIN 13
#define IN_WA2 14
#define IN_BA2 15
#define IN_ANG 16
#define IN_SINK 17
#define IN_T5 18
#define IN_CREL 19
#define IN_WOUT 20
#define IN_WUP 21
#define IN_WDN 22
#define IN_GFIN 23

__device__ __forceinline__ int win_colmap(int n) { return n < 1536 ? n : (n < 2816 ? n + 16 : (n < 2832 ? n - 2816 + 1536 : -1)); }
template <bool WINMAP>
__device__ __forceinline__ void p0_transpose_item(const float* W, int K, int Nsrc, int Npad, bf16* WT, LAS float* scr, int item, int lane) {
    const int nblk = Npad / 32, kb = item / nblk, nb = item % nblk, k0 = 64 * kb, n0 = 32 * nb;
    const int nn = n0 + (lane & 31); const int sc = WINMAP ? win_colmap(nn) : nn;
#pragma unroll 8
    for (int i = 0; i < 32; ++i) { const int kk = 2 * i + (lane >> 5); scr[kk * 33 + (lane & 31)] = (sc >= 0) ? W[(size_t)(k0 + kk) * Nsrc + sc] : 0.f; }
    LDS_WAIT(); asm volatile("" ::: "memory");
    const int c = lane & 7;
#pragma unroll
    for (int j = 0; j < 4; ++j) { const int n = (lane >> 3) + 8 * j; const LAS float* s = scr + (8 * c) * 33 + n;
        v4u o; o.x = pk2(s[0 * 33], s[1 * 33]); o.y = pk2(s[2 * 33], s[3 * 33]); o.z = pk2(s[4 * 33], s[5 * 33]); o.w = pk2(s[6 * 33], s[7 * 33]);
        *(GAS v4u*)(WT + (size_t)(n0 + n) * K + k0 + 8 * c) = o; }
    LDS_WAIT(); asm volatile("" ::: "memory");
}
__device__ __forceinline__ void p0_transposes(Frame& F) {
    LAS float* scr = (LAS float*)(F.lds + RING_OFF + F.wave * 16384);
    const int gw = F.vcu * NWAVES + F.wave, NGW = F.G * NWAVES;
    constexpr int I_IN = 16 * 96, I_OUT = 16 * 32, I_UP = 16 * 128, I_DN = 64 * 32, I_L = I_IN + I_OUT + I_UP + I_DN;
    for (int it = gw; it < DEPTH * I_L; it += NGW) {
        const int l = it / I_L; int r = it % I_L;
        if (r < I_IN) { p0_transpose_item<true>(INP(IN_WIN) + (size_t)l * DM * NIN_SRC, DM, NIN_SRC, NINP, (bf16*)(F.ws + WS_WIN) + (size_t)l * NINP * DM, scr, r, F.lane); continue; } r -= I_IN;
        if (r < I_OUT) { p0_transpose_item<false>(INP(IN_WOUT) + (size_t)l * DM * DM, DM, DM, DM, (bf16*)(F.ws + WS_WOUT) + (size_t)l * DM * DM, scr, r, F.lane); continue; } r -= I_OUT;
        if (r < I_UP) { p0_transpose_item<false>(INP(IN_WUP) + (size_t)l * DM * DFF, DM, DFF, DFF, (bf16*)(F.ws + WS_WUP) + (size_t)l * DFF * DM, scr, r, F.lane); continue; } r -= I_UP;
        p0_transpose_item<false>(INP(IN_WDN) + (size_t)l * DFF * DM, DFF, DM, DM, (bf16*)(F.ws + WS_WDN) + (size_t)l * DM * DFF, scr, r, F.lane);
    }
}
template <int MODE>
__device__ __forceinline__ void skinny_item(Frame& F, int l, int item) {
    LAS float* A = (LAS float*)(F.lds);
    LAS float* RED = (LAS float*)(F.lds + 73728);
    const int n0 = item * 64, col = n0 + F.lane;
    const float* W; int ldw, scol; float* out; int ldo; float addb = 0.f;
    float* MOD = (float*)(F.ws + WS_MOD) + (size_t)l * NSEQ * NMOD;
    if (MODE == 0) { W = INP(IN_WADA) + (size_t)l * DM * NMOD; ldw = NMOD; scol = col; out = MOD; ldo = NMOD; }
    else if (MODE == 1) { W = INP(IN_WIN) + (size_t)l * DM * NIN_SRC; ldw = NIN_SRC; scol = win_colmap(col); out = (float*)(F.ws + WS_BIASM) + (size_t)l * NSEQ * NINP; ldo = NINP; }
    else { W = INP(IN_WUP) + (size_t)l * DM * DFF; ldw = DFF; scol = col; out = (float*)(F.ws + WS_BIASF) + (size_t)l * NSEQ * DFF; ldo = DFF; }
    float acc[36];
#pragma unroll
    for (int s = 0; s < 36; ++s) acc[s] = 0.f;
    for (int kh = 0; kh < 2; ++kh) {
        __syncthreads();
        { const int kk = F.tid, k = 512 * kh + kk;
#pragma unroll 1
          for (int s = 0; s < NSEQ; ++s) { float a;
              if (MODE == 0) { const float c = (s == 0) ? INP(IN_CP)[k] : INP(IN_CS)[(size_t)(s - 1) * DM + k]; a = silu_f(c); }
              else a = MOD[(size_t)s * NMOD + (MODE == 1 ? 0 : 3072) + k];
              A[kk * 36 + s] = a; }
          A[kk * 36 + 33] = 0.f; A[kk * 36 + 34] = 0.f; A[kk * 36 + 35] = 0.f; }
        __syncthreads();
        const int kb = F.wave * 64;
#pragma unroll 4
        for (int kk = kb; kk < kb + 64; ++kk) {
            const float wv = (scol >= 0) ? W[(size_t)(512 * kh + kk) * ldw + scol] : 0.f;
#pragma unroll
            for (int s4 = 0; s4 < 9; ++s4) { const f32x4 a4 = *(const LAS f32x4*)(A + kk * 36 + 4 * s4);
                acc[4 * s4 + 0] += a4[0] * wv; acc[4 * s4 + 1] += a4[1] * wv; acc[4 * s4 + 2] += a4[2] * wv; acc[4 * s4 + 3] += a4[3] * wv; }
        }
    }
#pragma unroll
    for (int s = 0; s < NSEQ; ++s) RED[(F.wave * NSEQ + s) * 64 + F.lane] = acc[s];
    __syncthreads();
    for (int idx = F.tid; idx < NSEQ * 64; idx += NWAVES * 64) { const int s = idx >> 6, ln = idx & 63; float sum = 0.f;
#pragma unroll
        for (int w = 0; w < NWAVES; ++w) sum += RED[(w * NSEQ + s) * 64 + ln];
        if (MODE == 0) sum += INP(IN_BADA)[(size_t)l * NMOD + n0 + ln];
        out[(size_t)s * ldo + n0 + ln] = sum; }
    __syncthreads();
}
__device__ __forceinline__ void xn0_row(Frame& F, int m) {
    const float* xrow = (m < NTP) ? INP(IN_XP) + (size_t)m * DM : INP(IN_XS) + (size_t)(m - NTP) * DM;
    const int s = m < NTP ? 0 : 1 + ((m - NTP) >> 6);
    const float* sc = (const float*)(F.ws + WS_MOD) + (size_t)s * NMOD + 1024; const float* g = INP(IN_GMIX);
    bf16* orow = (bf16*)(F.ws + WS_XN) + (size_t)m * DM;
    float ss = 0.f;
#pragma unroll
    for (int j = 0; j < 4; ++j) { const int c = 4 * (F.lane + 64 * j); const f32x4 v = *(const f32x4*)(xrow + c), gg = *(const f32x4*)(g + c), s4 = *(const f32x4*)(sc + c);
        ss += (v[0] * v[0] + v[1] * v[1]) + (v[2] * v[2] + v[3] * v[3]);
        const f32x4 y = v * (gg * (s4 + 1.0f)); v2u w; w.x = pk2(y[0], y[1]); w.y = pk2(y[2], y[3]); *(v2u*)(orow + c) = w; }
    ss = wave_sum(ss);
    if (F.lane < 16) ((float*)(F.ws + WS_ROWSQ))[(size_t)m * 16 + F.lane] = (F.lane == 0) ? ss : 0.f;
}
__device__ __forceinline__ void final_row(Frame& F, int m) {
    float* xrow = F.out + (size_t)m * DM; const float* g = INP(IN_GFIN);
    const float rs = pg8::rstd_of((const float*)(F.ws + WS_ROWSQ) + (size_t)m * 16);
#pragma unroll
    for (int j = 0; j < 4; ++j) { const int c = 4 * (F.lane + 64 * j); const f32x4 v = *(const f32x4*)(xrow + c), gg = *(const f32x4*)(g + c); *(f32x4*)(xrow + c) = v * rs * gg; }
}

__device__ __forceinline__ int t5_bucket_dev(int rel) {
    const int n = rel < 0 ? -rel : rel; int b;
    if (n < 8) b = n; else { const int lg = 31 - __clz(n * n); int large = 2 + lg; if (large > 15) large = 15; b = large; }
    return (rel > 0 ? 16 : 0) + b;
}
template <int MIX>
__device__ __forceinline__ void attn_simple(Frame& F, int l) {
    constexpr int T0 = MIX ? 8 : 2, NT = T0 + 1, LC = 64 * T0, NKV = MIX ? 4 : 2;
    constexpr int QC = MIX ? C_QC : C_QB, KC = MIX ? C_KC : C_KB, VC = MIX ? C_VC : C_VB, OC = MIX ? 768 : 512;
    const bf16* proj = (const bf16*)(F.ws + WS_PROJ); bf16* mixed = (bf16*)(F.ws + WS_MIXED);
    const float* ck = (MIX ? INP(IN_CCK) : INP(IN_CBK)) + (size_t)l * 32 * LC * NKV * 64; const float* cv = (MIX ? INP(IN_CCV) : INP(IN_CBV)) + (size_t)l * 32 * LC * NKV * 64;
    const float* t5 = INP(IN_T5); const float* crel = INP(IN_CREL) + (size_t)l * 513 * 4; const float* sinkp = INP(IN_SINK) + l * 4;
    const int gw = F.vcu * NWAVES + F.wave, NGW = F.G * NWAVES, lane = F.lane;
    for (int task = gw; task < MTOK * 4; task += NGW) {
        const int m = task >> 2, h = task & 3, kvh = MIX ? h : (h >> 1);
        const bool isp = m < NTP; const int q = m & 63; const int n = m >> 6; const int b = (m - NTP) >> 6;
        const float qd = bf2f(proj[(size_t)m * PLD + QC + 64 * h + lane]);
        LAS float* scl = (LAS float*)(F.lds) + F.wave * 640;
        float mx = -1e30f;
#pragma unroll 1
        for (int i = 0; i < NT; ++i) {
            const int j = lane + 64 * i; float dot = 0.f; bool valid = true;
            if (isp || i == T0) {
                const long tok = isp ? (long)64 * (n - T0) + j : (long)NTP + 64 * b + (j - LC);
                valid = tok >= 0;
                const v4u* kp = (const v4u*)(proj + (size_t)(valid ? tok : 0) * PLD + KC + 64 * kvh);
#pragma unroll 2
                for (int c = 0; c < 8; ++c) { const v4u kv = kp[c];
                    const unsigned w[4] = {kv.x, kv.y, kv.z, kv.w};
#pragma unroll
                    for (int e = 0; e < 4; ++e) { dot += __shfl(qd, 8 * c + 2 * e) * bflo(w[e]); dot += __shfl(qd, 8 * c + 2 * e + 1) * bfhi(w[e]); } }
            } else {
                const f32x4* kp = (const f32x4*)(ck + (((size_t)b * LC + j) * NKV + kvh) * 64);
#pragma unroll 2
                for (int c = 0; c < 16; ++c) { const f32x4 kv = kp[c];
#pragma unroll
                    for (int e = 0; e < 4; ++e) dot += __shfl(qd, 4 * c + e) * kv[e]; }
            }
            const int rel = j - LC - q; float bias;
            if (MIX) { int rc = rel < -256 ? -256 : (rel > 256 ? 256 : rel); bias = crel[(rc + 256) * 4 + h]; }
            else bias = t5[t5_bucket_dev(rel) * 4 + h];
            const float sv = valid ? dot * 0.125f + bias : -1e30f;
            scl[j] = sv; mx = fmaxf(mx, sv);
        }
        mx = wave_max(mx);
        float sk = 0.f; if (!MIX) { sk = sinkp[h]; mx = fmaxf(mx, sk); }
        float sum = 0.f;
#pragma unroll 1
        for (int i = 0; i < NT; ++i) { const float p = __expf(scl[lane + 64 * i] - mx); scl[lane + 64 * i] = p; sum += p; }
        sum = wave_sum(sum); if (!MIX) sum += __expf(sk - mx);
        const float inv = 1.0f / sum;
        LDS_WAIT();
        float o = 0.f;
#pragma unroll 1
        for (int i = 0; i < NT; ++i) {
            if (isp || i == T0) {
                const long tok0 = isp ? (long)64 * (n - T0 + i) : (long)NTP + 64 * b;
                if (tok0 >= 0) {
                    const bf16* vp = proj + (size_t)tok0 * PLD + VC + 64 * kvh + lane;
#pragma unroll 8
                    for (int jj = 0; jj < 64; ++jj) o += scl[64 * i + jj] * bf2f(vp[(size_t)jj * PLD]);
                }
            } else {
                const float* vp = cv + (((size_t)b * LC + 64 * i) * NKV + kvh) * 64 + lane;
#pragma unroll 8
                for (int jj = 0; jj < 64; ++jj) o += scl[64 * i + jj] * vp[(size_t)jj * NKV * 64];
            }
        }
        LDS_WAIT();
        mixed[(size_t)m * DM + OC + 64 * h + lane] = (bf16)f2bf(o * inv);
    }
}
__device__ __forceinline__ void cache_out_simple(Frame& F, int l) {
    const bf16* proj = (const bf16*)(F.ws + WS_PROJ);
    const size_t gt = (size_t)F.vcu * NWAVES * 64 + F.tid, NGT = (size_t)F.G * NWAVES * 64;
    for (size_t i = gt; i < 2 * 16384; i += NGT) { const int kv = (int)(i / 16384), e = (int)(i % 16384), row = e / 128, c = e % 128;
        F.out[(kv ? O_VBP : O_KBP) + (size_t)l * 16384 + e] = bf2f(proj[(size_t)(NTP - 128 + row) * PLD + (kv ? C_VB : C_KB) + c]); }
    for (size_t i = gt; i < 2 * 131072; i += NGT) { const int kv = (int)(i / 131072), e = (int)(i % 131072), row = e / 256, c = e % 256;
        F.out[(kv ? O_VCP : O_KCP) + (size_t)l * 131072 + e] = bf2f(proj[(size_t)(NTP - 512 + row) * PLD + (kv ? C_VC : C_KC) + c]); }
    for (size_t i = gt; i < 2 * 524288; i += NGT) { const int kv = (int)(i / 524288), e = (int)(i % 524288), b = e / 16384, row = (e % 16384) / 128, c = e % 128;
        float v;
        if (row < 64) v = (kv ? INP(IN_CBV) : INP(IN_CBK))[(size_t)l * 524288 + (size_t)b * 16384 + (size_t)(row + 64) * 128 + c];
        else v = bf2f(proj[(size_t)(NTP + 64 * b + row - 64) * PLD + (kv ? C_VB : C_KB) + c]);
        F.out[(kv ? O_VBS : O_KBS) + (size_t)l * 524288 + e] = v; }
    for (size_t i = gt; i < 2 * 4194304; i += NGT) { const int kv = (int)(i / 4194304), e = (int)(i % 4194304), b = e / 131072, row = (e % 131072) / 256, c = e % 256;
        float v;
        if (row < 448) v = (kv ? INP(IN_CCV) : INP(IN_CCK))[(size_t)l * 4194304 + (size_t)b * 131072 + (size_t)(row + 64) * 256 + c];
        else v = bf2f(proj[(size_t)(NTP + 64 * b + row - 448) * PLD + (kv ? C_VC : C_KC) + c]);
        F.out[(kv ? O_VCS : O_KCS) + (size_t)l * 4194304 + e] = v; }
}
__device__ __forceinline__ void gla_simple(Frame& F, int l) {
    const bf16* proj = (const bf16*)(F.ws + WS_PROJ); const float* RA = (const float*)(F.ws + WS_RA); float* OG = (float*)(F.ws + WS_XN);
    const int gw = F.vcu * NWAVES + F.wave, NGW = F.G * NWAVES, lane = F.lane;
    for (int task = gw; task < NSEQ * 512; task += NGW) {
        const int s = task / 512, h = (task % 512) / 128, dv = task % 128;
        const int row0 = s == 0 ? 0 : NTP + 64 * (s - 1), nrow = s == 0 ? NTP : 64;
        float S = s == 0 ? 0.f : INP(IN_SG)[((((size_t)l * 32 + (s - 1)) * 4 + h) * 64 + lane) * 128 + dv];
        float wc[16];
#pragma unroll
        for (int r = 0; r < 16; ++r) wc[r] = INP(IN_WA2)[((size_t)l * 16 + r) * 256 + h * 64 + lane];
        const float ba = INP(IN_BA2)[(size_t)l * 256 + h * 64 + lane];
#pragma unroll 4
        for (int t = 0; t < nrow; ++t) {
            const int m = row0 + t; const float* ra = RA + (size_t)m * 16;
            float x = ba;
#pragma unroll
            for (int r = 0; r < 16; ++r) x += ra[r] * wc[r];
            const float alpha = __expf(logsigmoid_f(x) * (1.0f / 16.0f));
            const float qv = bf2f(proj[(size_t)m * PLD + C_QA + 64 * h + lane]) * 0.125f, kv = bf2f(proj[(size_t)m * PLD + C_KA + 64 * h + lane]);
            const float vv = bf2f(proj[(size_t)m * PLD + C_VA + 128 * h + dv]);
            S = alpha * S + kv * vv;
            const float o = wave_sum(qv * S);
            if (lane == 0) OG[(size_t)m * 512 + h * 128 + dv] = o;
        }
        float* so = F.out + (s == 0 ? O_SGP + (size_t)l * 32768 : O_SGS + ((size_t)l * 32 + (s - 1)) * 32768);
        so[((size_t)h * 64 + lane) * 128 + dv] = S;
    }
}
__device__ __forceinline__ void gla_norm_simple(Frame& F, int l) {
    const bf16* proj = (const bf16*)(F.ws + WS_PROJ); const float* OG = (const float*)(F.ws + WS_XN); bf16* mixed = (bf16*)(F.ws + WS_MIXED);
    const float* ng = INP(IN_ANG) + l * 128;
    const int gw = F.vcu * NWAVES + F.wave, NGW = F.G * NWAVES, lane = F.lane;
    for (int task = gw; task < MTOK * 4; task += NGW) {
        const int m = task >> 2, h = task & 3;
        const float o0 = OG[(size_t)m * 512 + h * 128 + lane], o1 = OG[(size_t)m * 512 + h * 128 + 64 + lane];
        const float ss = wave_sum(o0 * o0 + o1 * o1); const float rs = 1.0f / sqrtf(ss * (1.0f / 128.0f) + EPS);
        const float g0 = bf2f(proj[(size_t)m * PLD + C_GA + 128 * h + lane]), g1 = bf2f(proj[(size_t)m * PLD + C_GA + 128 * h + 64 + lane]);
        mixed[(size_t)m * DM + h * 128 + lane] = (bf16)f2bf(o0 * rs * ng[lane] * silu_f(g0));
        mixed[(size_t)m * DM + h * 128 + 64 + lane] = (bf16)f2bf(o1 * rs * ng[64 + lane] * silu_f(g1));
    }
}

typedef short bf16x8v __attribute__((ext_vector_type(8)));
typedef short s16x4v __attribute__((ext_vector_type(4)));
typedef float f32x16 __attribute__((ext_vector_type(16)));
constexpr int AT_K = 0, AT_V = 36864, AT_BTC = 86016, AT_BTB = 96256, AT_WS = 100352, AT_QW = 102400;
constexpr float LOG2E = 1.4426950408889634f;
__device__ __forceinline__ int crow16(int r, int hi) { return (r & 3) + 8 * (r >> 2) + 4 * hi; }
__device__ __forceinline__ s16x4v ds_tr16(const LAS unsigned char* p) { return __builtin_bit_cast(s16x4v, __builtin_amdgcn_ds_read_tr16_b64_v4i16((LAS s16x4v*)p)); }
__device__ __forceinline__ unsigned cvtpk(float lo, float hi) { unsigned r; asm volatile("v_cvt_pk_bf16_f32 %0, %1, %2" : "=v"(r) : "v"(lo), "v"(hi)); return r; }

__device__ __forceinline__ void attn_build_tables(Frame& F, int l) {
    const float* crel = INP(IN_CREL) + (size_t)l * 513 * 4; const float* t5 = INP(IN_T5);
    LAS float* bc = (LAS float*)(F.lds + AT_BTC); LAS float* bb = (LAS float*)(F.lds + AT_BTB);
    for (int i = F.tid; i < 4 * 640; i += NWAVES * 64) { const int h = i / 640, idx = i % 640; int rel = idx - 575; rel = rel < -256 ? -256 : (rel > 256 ? 256 : rel); bc[i] = crel[(rel + 256) * 4 + h] * LOG2E; }
    for (int i = F.tid; i < 4 * 256; i += NWAVES * 64) { const int h = i / 256, idx = i % 256; bb[i] = t5[t5_bucket_dev(idx - 191) * 4 + h] * LOG2E; }
    __syncthreads();
}

template <int MIX>
__device__ __forceinline__ void attn_unit(Frame& F, int l, int n) {
    constexpr int T0 = MIX ? 8 : 2, NKV = MIX ? 4 : 2, NCH = 8 * NKV, LC = 64 * T0, RP = NKV * 64;
    constexpr int QC = MIX ? C_QC : C_QB, KC = MIX ? C_KC : C_KB, VC = MIX ? C_VC : C_VB, OC = MIX ? 768 : 512;
    constexpr float C2 = 0.125f * LOG2E;
    const bf16* proj = (const bf16*)(F.ws + WS_PROJ); bf16* mixed = (bf16*)(F.ws + WS_MIXED);
    const int tid = F.tid, lane = F.lane, wave = F.wave, head = wave >> 1, qh = wave & 1, kvh = MIX ? head : (head >> 1), r32 = lane & 31, hi = lane >> 5;
    const bool isp = n < 256; const int b = n - 256; const int row0 = isp ? 64 * n : NTP + 64 * b;
    bf16x8v qf[4];
    { const bf16* qp = proj + (size_t)(row0 + 32 * qh + r32) * PLD + QC + 64 * head + 8 * hi;
#pragma unroll
      for (int d0 = 0; d0 < 4; ++d0) qf[d0] = *(const bf16x8v*)(qp + 16 * d0); }
    float m_run, l_run; f32x16 o0, o1;
#pragma unroll
    for (int r = 0; r < 16; ++r) { o0[r] = 0.f; o1[r] = 0.f; }
    if (MIX) { m_run = -1e30f; l_run = 0.f; } else { m_run = INP(IN_SINK)[l * 4 + head] * LOG2E; l_run = (hi == 0) ? 1.f : 0.f; }
    LAS float* wsf = (LAS float*)(F.lds + AT_WS) + wave * 64;
    const LAS float* BT = (const LAS float*)(F.lds + (MIX ? AT_BTC : AT_BTB)) + head * (MIX ? 640 : 256);
    const LAS unsigned char* Kb = F.lds + AT_K + kvh * 9216 + r32 * 144 + hi * 16;
    const LAS unsigned char* Vb = F.lds + AT_V + kvh * 12288 + (4 * hi + ((lane & 15) >> 2)) * 192 + ((lane >> 4) & 1) * 32 + (lane & 3) * 8;
    const float* cki = (MIX ? INP(IN_CCK) : INP(IN_CBK)) + ((size_t)l * 32 + (isp ? 0 : b)) * LC * RP;
    const float* cvi = (MIX ? INP(IN_CCV) : INP(IN_CBV)) + ((size_t)l * 32 + (isp ? 0 : b)) * LC * RP;
    float* oko = F.out + (isp ? (MIX ? O_KCP : O_KBP) + (size_t)l * LC * RP : (MIX ? O_KCS : O_KBS) + ((size_t)l * 32 + b) * LC * RP);
    float* ovo = F.out + (isp ? (MIX ? O_VCP : O_VBP) + (size_t)l * LC * RP : (MIX ? O_VCS : O_VBS) + ((size_t)l * 32 + b) * LC * RP);

#define ATT_COMPUTE(t_) do { \
        f32x16 p0, p1; \
        _Pragma("unroll") for (int r = 0; r < 16; ++r) { p0[r] = 0.f; p1[r] = 0.f; } \
        _Pragma("unroll") for (int d0 = 0; d0 < 4; ++d0) { \
            const bf16x8v kf0 = *(const LAS bf16x8v*)(Kb + d0 * 32), kf1 = *(const LAS bf16x8v*)(Kb + 32 * 144 + d0 * 32); \
            p0 = __builtin_amdgcn_mfma_f32_32x32x16_bf16(kf0, qf[d0], p0, 0, 0, 0); p1 = __builtin_amdgcn_mfma_f32_32x32x16_bf16(kf1, qf[d0], p1, 0, 0, 0); } \
        const int bi = 64 * (t_) + 63 - (32 * qh + r32) + 4 * hi; float tmax = -1e30f; \
        _Pragma("unroll") for (int r = 0; r < 16; ++r) { const int k = (r & 3) + 8 * (r >> 2); \
            p0[r] = p0[r] * C2 + BT[bi + k]; p1[r] = p1[r] * C2 + BT[bi + k + 32]; tmax = fmaxf(tmax, fmaxf(p0[r], p1[r])); } \
        tmax = fmaxf(tmax, __shfl_xor(tmax, 32)); \
        const float mnew = fmaxf(m_run, tmax), alpha = __builtin_amdgcn_exp2f(m_run - mnew); m_run = mnew; \
        float ps = 0.f; \
        _Pragma("unroll") for (int r = 0; r < 16; ++r) { p0[r] = __builtin_amdgcn_exp2f(p0[r] - mnew); p1[r] = __builtin_amdgcn_exp2f(p1[r] - mnew); ps += p0[r] + p1[r]; } \
        l_run = l_run * alpha + ps; \
        if (!__all(alpha == 1.0f)) { if (hi == 0) wsf[r32] = alpha; \
            _Pragma("unroll") for (int r = 0; r < 16; ++r) { const float a = wsf[crow16(r, hi)]; o0[r] *= a; o1[r] *= a; } } \
        bf16x8v pa[4]; \
        { v4u w; w.x = cvtpk(p0[0], p0[1]); w.y = cvtpk(p0[2], p0[3]); w.z = cvtpk(p0[4], p0[5]); w.w = cvtpk(p0[6], p0[7]); pa[0] = __builtin_bit_cast(bf16x8v, w); \
          w.x = cvtpk(p0[8], p0[9]); w.y = cvtpk(p0[10], p0[11]); w.z = cvtpk(p0[12], p0[13]); w.w = cvtpk(p0[14], p0[15]); pa[1] = __builtin_bit_cast(bf16x8v, w); \
          w.x = cvtpk(p1[0], p1[1]); w.y = cvtpk(p1[2], p1[3]); w.z = cvtpk(p1[4], p1[5]); w.w = cvtpk(p1[6], p1[7]); pa[2] = __builtin_bit_cast(bf16x8v, w); \
          w.x = cvtpk(p1[8], p1[9]); w.y = cvtpk(p1[10], p1[11]); w.z = cvtpk(p1[12], p1[13]); w.w = cvtpk(p1[14], p1[15]); pa[3] = __builtin_bit_cast(bf16x8v, w); } \
        _Pragma("unroll") for (int ks = 0; ks < 4; ++ks) { \
            const s16x4v a0 = ds_tr16(Vb + ks * 16 * 192), a1 = ds_tr16(Vb + ks * 16 * 192 + 8 * 192), c0 = ds_tr16(Vb + ks * 16 * 192 + 64), c1 = ds_tr16(Vb + ks * 16 * 192 + 8 * 192 + 64); \
            const bf16x8v v0 = (bf16x8v){a0[0], a0[1], a0[2], a0[3], a1[0], a1[1], a1[2], a1[3]}, v1 = (bf16x8v){c0[0], c0[1], c0[2], c0[3], c1[0], c1[1], c1[2], c1[3]}; \
            o0 = __builtin_amdgcn_mfma_f32_32x32x16_bf16(pa[ks], v0, o0, 0, 0, 0); o1 = __builtin_amdgcn_mfma_f32_32x32x16_bf16(pa[ks], v1, o1, 0, 0, 0); } \
    } while (0)

    if (!isp) {
        f32x4 kr[2 * NKV], vr[2 * NKV];
#define ATT_LOADF(t_) do { _Pragma("unroll") for (int i = 0; i < NKV; ++i) { const int ci = tid + 512 * i, row = ci / NCH, cc = ci % NCH; \
            const float* kp = cki + (size_t)(64 * (t_) + row) * RP + cc * 8; const float* vp = cvi + (size_t)(64 * (t_) + row) * RP + cc * 8; \
            kr[2 * i] = *(const f32x4*)kp; kr[2 * i + 1] = *(const f32x4*)(kp + 4); vr[2 * i] = *(const f32x4*)vp; vr[2 * i + 1] = *(const f32x4*)(vp + 4); } } while (0)
        for (int t = 0; t < T0; ++t) {
            __syncthreads();
            ATT_LOADF(t);
#pragma unroll
            for (int i = 0; i < NKV; ++i) { const int ci = tid + 512 * i, row = ci / NCH, cc = ci % NCH, hd = cc >> 3, c8 = cc & 7;
                v4u kw, vw; kw.x = pk2(kr[2 * i][0], kr[2 * i][1]); kw.y = pk2(kr[2 * i][2], kr[2 * i][3]); kw.z = pk2(kr[2 * i + 1][0], kr[2 * i + 1][1]); kw.w = pk2(kr[2 * i + 1][2], kr[2 * i + 1][3]);
                vw.x = pk2(vr[2 * i][0], vr[2 * i][1]); vw.y = pk2(vr[2 * i][2], vr[2 * i][3]); vw.z = pk2(vr[2 * i + 1][0], vr[2 * i + 1][1]); vw.w = pk2(vr[2 * i + 1][2], vr[2 * i + 1][3]);
                *(LAS v4u*)(F.lds + AT_K + hd * 9216 + row * 144 + c8 * 16) = kw; *(LAS v4u*)(F.lds + AT_V + hd * 12288 + row * 192 + c8 * 16) = vw;
                if (t >= 1) { float* ok = oko + (size_t)(64 * (t - 1) + row) * RP + cc * 8; float* ov = ovo + (size_t)(64 * (t - 1) + row) * RP + cc * 8;
                    *(f32x4*)ok = kr[2 * i]; *(f32x4*)(ok + 4) = kr[2 * i + 1]; *(f32x4*)ov = vr[2 * i]; *(f32x4*)(ov + 4) = vr[2 * i + 1]; } }
            __syncthreads();
            ATT_COMPUTE(t);
        }
#undef ATT_LOADF
    }
    {
        const int tb = isp ? (T0 - n > 0 ? T0 - n : 0) : T0;
        v4u kr[NKV], vr[NKV];
#define ATT_LOADB(t_) do { const int srow = isp ? 64 * (n - T0 + (t_)) : row0; \
        _Pragma("unroll") for (int i = 0; i < NKV; ++i) { const int ci = tid + 512 * i, row = ci / NCH, cc = ci % NCH; \
            kr[i] = *(const v4u*)(proj + (size_t)(srow + row) * PLD + KC + cc * 8); vr[i] = *(const v4u*)(proj + (size_t)(srow + row) * PLD + VC + cc * 8); } } while (0)
        const bool wr_out = isp ? (n >= 256 - T0) : true; const int orow0 = isp ? 64 * (n - (256 - T0)) : 64 * (T0 - 1);
        for (int t = tb; t <= T0; ++t) {
            __syncthreads();
            ATT_LOADB(t);
#pragma unroll
            for (int i = 0; i < NKV; ++i) { const int ci = tid + 512 * i, row = ci / NCH, cc = ci % NCH, hd = cc >> 3, c8 = cc & 7;
                *(LAS v4u*)(F.lds + AT_K + hd * 9216 + row * 144 + c8 * 16) = kr[i]; *(LAS v4u*)(F.lds + AT_V + hd * 12288 + row * 192 + c8 * 16) = vr[i];
                if (t == T0 && wr_out) { float* ok = oko + (size_t)(orow0 + row) * RP + cc * 8; float* ov = ovo + (size_t)(orow0 + row) * RP + cc * 8;
                    *(f32x4*)ok = (f32x4){bflo(kr[i].x), bfhi(kr[i].x), bflo(kr[i].y), bfhi(kr[i].y)}; *(f32x4*)(ok + 4) = (f32x4){bflo(kr[i].z), bfhi(kr[i].z), bflo(kr[i].w), bfhi(kr[i].w)};
                    *(f32x4*)ov = (f32x4){bflo(vr[i].x), bfhi(vr[i].x), bflo(vr[i].y), bfhi(vr[i].y)}; *(f32x4*)(ov + 4) = (f32x4){bflo(vr[i].z), bfhi(vr[i].z), bflo(vr[i].w), bfhi(vr[i].w)}; } }
            __syncthreads();
            ATT_COMPUTE(t);
        }
#undef ATT_LOADB
    }
#undef ATT_COMPUTE
    { const float lt = l_run + __shfl_xor(l_run, 32); if (hi == 0) wsf[r32] = 1.0f / lt; }
    __syncthreads();
    { LAS bf16* stg = (LAS bf16*)(F.lds + AT_K) + wave * 2048;
#pragma unroll
      for (int r = 0; r < 16; ++r) { const int q = crow16(r, hi); const float a = wsf[q];
          stg[q * 64 + r32] = (bf16)f2bf(o0[r] * a); stg[q * 64 + 32 + r32] = (bf16)f2bf(o1[r] * a); }
      LDS_WAIT();
#pragma unroll
      for (int i = 0; i < 4; ++i) { const int row = i * 8 + (lane >> 3), ch = lane & 7; const v4u v = *(const LAS v4u*)(stg + row * 64 + ch * 8);
          *(v4u*)(mixed + (size_t)(row0 + 32 * qh + row) * DM + OC + 64 * head + ch * 8) = v; } }
}
template <int NGLA>
__device__ __forceinline__ void mix1_phase(Frame& F, int l);

constexpr int GL_RA = 0, GL_TOT = 4096, GL_KH = 6144, GL_V = 18432;
constexpr int G3_Q = 0, G3_K = 9216, G3_V = 18432, G3_S = 38912, G3_O = 59392;

__device__ __forceinline__ void gla_local_unit(Frame& F, int l, int n, int h) {
    bf16* proj = (bf16*)(F.ws + WS_PROJ); const float* RAg = (const float*)(F.ws + WS_RA);
    float* UB = (float*)(F.ws + WS_XN); float* DN = (float*)(F.ws + WS_DN);
    const int tid = F.tid, lane = F.lane, wave = F.wave, row0 = 64 * n, dk = tid & 63, g = tid >> 6, hi = lane >> 5;
    __syncthreads();
    if (tid < 256) { const f32x4 v = *(const f32x4*)(RAg + (size_t)row0 * 16 + tid * 4); *(LAS f32x4*)(F.lds + GL_RA + tid * 16) = v; }
#pragma unroll
    for (int i = 0; i < 2; ++i) { const int ci = tid + 512 * i, row = ci >> 4, c16 = ci & 15;
        const v4u v = *(const v4u*)(proj + (size_t)(row0 + row) * PLD + C_VA + 128 * h + c16 * 8); *(LAS v4u*)(F.lds + GL_V + row * 320 + c16 * 16) = v; }
    float wc[16];
    { const float* wa = INP(IN_WA2) + (size_t)l * 16 * 256 + h * 64 + dk;
#pragma unroll
      for (int r = 0; r < 16; ++r) wc[r] = wa[r * 256]; }
    const float ba = INP(IN_BA2)[(size_t)l * 256 + h * 64 + dk];
    float qv[8], kv[8];
#pragma unroll
    for (int i = 0; i < 8; ++i) { const size_t m = (size_t)(row0 + 8 * g + i) * PLD; qv[i] = bf2f(proj[m + C_QA + 64 * h + dk]); kv[i] = bf2f(proj[m + C_KA + 64 * h + dk]); }
    __syncthreads();
    float c[8]; float run = 0.f;
#pragma unroll
    for (int i = 0; i < 8; ++i) { const int t = 8 * g + i; float x = ba;
#pragma unroll
        for (int r4 = 0; r4 < 4; ++r4) { const f32x4 a = *(const LAS f32x4*)(F.lds + GL_RA + t * 64 + r4 * 16);
            x += a[0] * wc[4 * r4] + a[1] * wc[4 * r4 + 1] + a[2] * wc[4 * r4 + 2] + a[3] * wc[4 * r4 + 3]; }
        run += logsigmoid_f(x) * (1.0f / 16.0f); c[i] = run; }
    ((LAS float*)(F.lds + GL_TOT))[g * 64 + dk] = run;
    __syncthreads();
    float off = 0.f, blast = 0.f;
#pragma unroll
    for (int g2 = 0; g2 < 8; ++g2) { const float tv = ((const LAS float*)(F.lds + GL_TOT))[g2 * 64 + dk]; blast += tv; if (g2 < g) off += tv; }
#pragma unroll
    for (int i = 0; i < 8; ++i) { const float b = off + c[i]; const size_t m = (size_t)(row0 + 8 * g + i) * PLD;
        proj[m + C_QA + 64 * h + dk] = (bf16)f2bf(qv[i] * __expf(b) * 0.125f);
        proj[m + C_KA + 64 * h + dk] = (bf16)f2bf(kv[i] * __expf(-b));
        ((LAS bf16*)(F.lds + GL_KH))[(8 * g + i) * 96 + dk] = (bf16)f2bf(kv[i] * __expf(blast - b)); }
    if (g == 0) DN[((size_t)n * 4 + h) * 64 + dk] = __expf(blast);
    __syncthreads();
    { const int dkh = wave & 1, dvq = wave >> 1; f32x16 acc;
#pragma unroll
      for (int r = 0; r < 16; ++r) acc[r] = 0.f;
      const int rsel = 4 * hi + ((lane & 15) >> 2), csel = ((lane >> 4) & 1) * 32 + (lane & 3) * 8;
      const LAS unsigned char* Ab = F.lds + GL_KH + rsel * 192 + dkh * 64 + csel;
      const LAS unsigned char* Bb = F.lds + GL_V + rsel * 320 + dvq * 64 + csel;
#pragma unroll
      for (int ks = 0; ks < 4; ++ks) {
          const s16x4v a0 = ds_tr16(Ab + ks * 16 * 192), a1 = ds_tr16(Ab + ks * 16 * 192 + 8 * 192), b0 = ds_tr16(Bb + ks * 16 * 320), b1 = ds_tr16(Bb + ks * 16 * 320 + 8 * 320);
          const bf16x8v av = (bf16x8v){a0[0], a0[1], a0[2], a0[3], a1[0], a1[1], a1[2], a1[3]}, bv = (bf16x8v){b0[0], b0[1], b0[2], b0[3], b1[0], b1[1], b1[2], b1[3]};
          acc = __builtin_amdgcn_mfma_f32_32x32x16_bf16(av, bv, acc, 0, 0, 0); }
      float* up = UB + (((size_t)n * 4 + h) * 64 + 32 * dkh) * 128 + 32 * dvq + (lane & 31);
#pragma unroll
      for (int r = 0; r < 16; ++r) up[(size_t)crow16(r, hi) * 128] = acc[r]; }
}

__device__ __forceinline__ void gla_scan(Frame& F, int l) {
    const float* UB = (const float*)(F.ws + WS_XN); const float* DN = (const float*)(F.ws + WS_DN); bf16* SST = (bf16*)(F.ws + WS_SST);
    const int G = F.G, wg = blockIdx.x, tid = F.tid;
    for (int it = wg; it < 64; it += G) { const int e = it * 512 + tid, hd = e >> 7; float S = 0.f;
#pragma unroll 8
        for (int n = 0; n < 256; ++n) { const size_t idx = (size_t)n * 32768 + e; SST[idx] = (bf16)f2bf(S); S = DN[n * 256 + hd] * S + UB[idx]; }
        F.out[O_SGP + (size_t)l * 32768 + e] = S; }
    const int first = G > 64 ? 64 : 0, nw = G - first;
    if (wg >= first) { const float* sg = INP(IN_SG);
        for (int j = wg - first; j < 2048; j += nw) { const int b = j >> 6, e = (j & 63) * 512 + tid, n = 256 + b; const size_t idx = (size_t)n * 32768 + e;
            const float Sin = sg[((size_t)l * 32 + b) * 32768 + e]; SST[idx] = (bf16)f2bf(Sin);
            F.out[O_SGS + ((size_t)l * 32 + b) * 32768 + e] = DN[n * 256 + (e >> 7)] * Sin + UB[idx]; } }
}

__device__ __forceinline__ void gla_out_unit(Frame& F, int l, int n, int h) {
    const bf16* proj = (const bf16*)(F.ws + WS_PROJ); const bf16* SST = (const bf16*)(F.ws + WS_SST); bf16* mixed = (bf16*)(F.ws + WS_MIXED);
    const int tid = F.tid, lane = F.lane, wave = F.wave, row0 = 64 * n, r32 = lane & 31, hi = lane >> 5;
    __syncthreads();
    { const int row = tid >> 3, c8 = tid & 7;
      *(LAS v4u*)(F.lds + G3_Q + row * 144 + c8 * 16) = *(const v4u*)(proj + (size_t)(row0 + row) * PLD + C_QA + 64 * h + c8 * 8);
      *(LAS v4u*)(F.lds + G3_K + row * 144 + c8 * 16) = *(const v4u*)(proj + (size_t)(row0 + row) * PLD + C_KA + 64 * h + c8 * 8); }
#pragma unroll
    for (int i = 0; i < 2; ++i) { const int ci = tid + 512 * i, row = ci >> 4, c16 = ci & 15;
        *(LAS v4u*)(F.lds + G3_V + row * 320 + c16 * 16) = *(const v4u*)(proj + (size_t)(row0 + row) * PLD + C_VA + 128 * h + c16 * 8);
        *(LAS v4u*)(F.lds + G3_S + row * 320 + c16 * 16) = *(const v4u*)(SST + (((size_t)n * 4 + h) * 64 + row) * 128 + c16 * 8); }
    __syncthreads();
    { const int th = wave & 1, dq = wave >> 1;
      bf16x8v qf[4];
#pragma unroll
      for (int d0 = 0; d0 < 4; ++d0) qf[d0] = *(const LAS bf16x8v*)(F.lds + G3_Q + (32 * th + r32) * 144 + d0 * 32 + hi * 16);
      f32x16 p0, p1;
#pragma unroll
      for (int r = 0; r < 16; ++r) { p0[r] = 0.f; p1[r] = 0.f; }
#pragma unroll
      for (int d0 = 0; d0 < 4; ++d0) { const bf16x8v kf0 = *(const LAS bf16x8v*)(F.lds + G3_K + r32 * 144 + d0 * 32 + hi * 16), kf1 = *(const LAS bf16x8v*)(F.lds + G3_K + (32 + r32) * 144 + d0 * 32 + hi * 16);
          p0 = __builtin_amdgcn_mfma_f32_32x32x16_bf16(kf0, qf[d0], p0, 0, 0, 0); p1 = __builtin_amdgcn_mfma_f32_32x32x16_bf16(kf1, qf[d0], p1, 0, 0, 0); }
      const int tabs = 32 * th + r32;
#pragma unroll
      for (int r = 0; r < 16; ++r) { const int s = crow16(r, hi); if (s > tabs) p0[r] = 0.f; if (s + 32 > tabs) p1[r] = 0.f; }
      bf16x8v pa[4];
      { v4u w; w.x = cvtpk(p0[0], p0[1]); w.y = cvtpk(p0[2], p0[3]); w.z = cvtpk(p0[4], p0[5]); w.w = cvtpk(p0[6], p0[7]); pa[0] = __builtin_bit_cast(bf16x8v, w);
        w.x = cvtpk(p0[8], p0[9]); w.y = cvtpk(p0[10], p0[11]); w.z = cvtpk(p0[12], p0[13]); w.w = cvtpk(p0[14], p0[15]); pa[1] = __builtin_bit_cast(bf16x8v, w);
        w.x = cvtpk(p1[0], p1[1]); w.y = cvtpk(p1[2], p1[3]); w.z = cvtpk(p1[4], p1[5]); w.w = cvtpk(p1[6], p1[7]); pa[2] = __builtin_bit_cast(bf16x8v, w);
        w.x = cvtpk(p1[8], p1[9]); w.y = cvtpk(p1[10], p1[11]); w.z = cvtpk(p1[12], p1[13]); w.w = cvtpk(p1[14], p1[15]); pa[3] = __builtin_bit_cast(bf16x8v, w); }
      f32x16 o;
#pragma unroll
      for (int r = 0; r < 16; ++r) o[r] = 0.f;
      const int csel = dq * 64 + ((lane >> 4) & 1) * 32 + (lane & 3) * 8, q4 = (lane & 15) >> 2;
      const LAS unsigned char* Vb = F.lds + G3_V + (4 * hi + q4) * 320 + csel;
      const LAS unsigned char* Sb = F.lds + G3_S + (8 * hi + q4) * 320 + csel;
#pragma unroll
      for (int ks = 0; ks < 4; ++ks) {
          const s16x4v a0 = ds_tr16(Vb + ks * 16 * 320), a1 = ds_tr16(Vb + ks * 16 * 320 + 8 * 320);
          const bf16x8v vv = (bf16x8v){a0[0], a0[1], a0[2], a0[3], a1[0], a1[1], a1[2], a1[3]};
          o = __builtin_amdgcn_mfma_f32_32x32x16_bf16(pa[ks], vv, o, 0, 0, 0); }
#pragma unroll
      for (int ks = 0; ks < 4; ++ks) {
          const s16x4v a0 = ds_tr16(Sb + ks * 16 * 320), a1 = ds_tr16(Sb + ks * 16 * 320 + 4 * 320);
          const bf16x8v sv = (bf16x8v){a0[0], a0[1], a0[2], a0[3], a1[0], a1[1], a1[2], a1[3]};
          o = __builtin_amdgcn_mfma_f32_32x32x16_bf16(qf[ks], sv, o, 0, 0, 0); }
      LAS float* og = (LAS float*)(F.lds + G3_O);
#pragma unroll
      for (int r = 0; r < 16; ++r) og[(32 * th + crow16(r, hi)) * 132 + 32 * dq + r32] = o[r]; }
    __syncthreads();
    { const int t = tid >> 3, seg = tid & 7; const LAS float* og = (const LAS float*)(F.lds + G3_O) + t * 132 + 16 * seg;
      float v[16]; float ss = 0.f;
#pragma unroll
      for (int j4 = 0; j4 < 4; ++j4) { const f32x4 a = *(const LAS f32x4*)(og + 4 * j4); v[4 * j4] = a[0]; v[4 * j4 + 1] = a[1]; v[4 * j4 + 2] = a[2]; v[4 * j4 + 3] = a[3];
          ss += (a[0] * a[0] + a[1] * a[1]) + (a[2] * a[2] + a[3] * a[3]); }
      ss += __shfl_xor(ss, 1); ss += __shfl_xor(ss, 2); ss += __shfl_xor(ss, 4);
      const float rs = 1.0f / sqrtf(ss * (1.0f / 128.0f) + EPS);
      const bf16* gp = proj + (size_t)(row0 + t) * PLD + C_GA + 128 * h + 16 * seg; const float* ng = INP(IN_ANG) + l * 128 + 16 * seg;
      const v4u g0 = *(const v4u*)gp, g1 = *(const v4u*)(gp + 8);
      const unsigned gw[8] = {g0.x, g0.y, g0.z, g0.w, g1.x, g1.y, g1.z, g1.w};
      unsigned ow[8];
#pragma unroll
      for (int j = 0; j < 8; ++j) { const float ga = bflo(gw[j]), gb = bfhi(gw[j]);
          ow[j] = pk2(v[2 * j] * rs * ng[2 * j] * silu_f(ga), v[2 * j + 1] * rs * ng[2 * j + 1] * silu_f(gb)); }
      bf16* op = mixed + (size_t)(row0 + t) * DM + 128 * h + 16 * seg;
      *(v4u*)op = (v4u){ow[0], ow[1], ow[2], ow[3]}; *(v4u*)(op + 8) = (v4u){ow[4], ow[5], ow[6], ow[7]}; }
}
__device__ __forceinline__ void gla_out_phase(Frame& F, int l) {
    gu32* head = F.ctl + CW_Q + 64 * (3 * l + 2);
    volatile LAS unsigned* qw = (volatile LAS unsigned*)(F.lds + AT_QW);
    for (;;) {
        if (F.tid == 0) qw[0] = __hip_atomic_fetch_add(head, 1u, RLX_AGENT);
        __syncthreads();
        const unsigned u = qw[0];
        __syncthreads();
        if (u >= 1152u) break;
        gla_out_unit(F, l, (int)(u >> 2), (int)(u & 3));
    }
}

template <int NGLA>
__device__ __forceinline__ void mix1_phase(Frame& F, int l) {
    attn_build_tables(F, l);
    volatile LAS unsigned* qw = (volatile LAS unsigned*)(F.lds + AT_QW);
    { gu32* head = F.ctl + CW_Q + 64 * (3 * l);
      for (;;) {
        if (F.tid == 0) qw[0] = __hip_atomic_fetch_add(head, 1u, RLX_AGENT);
        __syncthreads();
        const unsigned u = qw[0];
        __syncthreads();
        if (u >= 576u) break;
        if (u < 32u) attn_unit<1>(F, l, 256 + (int)u);
        else if (u < 288u) attn_unit<1>(F, l, (int)u - 32);
        else if (u < 320u) attn_unit<0>(F, l, 256 + (int)u - 288);
        else attn_unit<0>(F, l, (int)u - 320);
      } }
    if (NGLA) { gu32* head = F.ctl + CW_Q + 64 * (3 * l + 1);
      for (;;) {
        if (F.tid == 0) qw[0] = __hip_atomic_fetch_add(head, 1u, RLX_AGENT);
        __syncthreads();
        const unsigned u = qw[0];
        __syncthreads();
        if (u >= (unsigned)NGLA) break;
        gla_local_unit(F, l, (int)(u >> 2), (int)(u & 3));
      } }
}

#ifndef FAST_ATTN
#define FAST_ATTN 1
#endif
#ifndef FAST_GLA
#define FAST_GLA 1
#endif
#ifndef PHMASK
#define PHMASK 1023
#endif
#ifndef MK_ONE_LAUNCH
#define MK_ONE_LAUNCH 1
#endif
constexpr int PH_P0 = 0, PH_P1 = 1, PH_L0 = 2, PH_PER_LAYER = 7, PH_FINAL = PH_L0 + DEPTH * PH_PER_LAYER, N_PHASES = PH_FINAL + 1;

__global__ void __launch_bounds__(NWAVES * 64, 2) enc_fwd(Args args) {
    extern __shared__ __attribute__((aligned(16))) unsigned char lds[];
    Frame F;
    F.lds = (LAS unsigned char*)lds;
    F.MISC = (volatile LAS unsigned*)(F.lds + MISC_OFF);
    F.tid = threadIdx.x; F.lane = F.tid & 63; F.wave = __builtin_amdgcn_readfirstlane(F.tid >> 6);
    F.G = gridDim.x; { const int bx = blockIdx.x; F.vcu = (F.G % 8 == 0) ? (bx % 8) * (F.G / 8) + bx / 8 : bx; }
    F.out = args.out; F.ws = args.ws; F.ctl = (gu32*)(args.ws + WS_CTL);
    for (int u = F.tid; u < (LDS_BYTES - LDSCTL_OFF) / 4; u += NWAVES * 64) ((LAS unsigned*)(F.lds + LDSCTL_OFF))[u] = 0u;
    __syncthreads();
    if (F.tid == 0) { LAS unsigned long long* t = (LAS unsigned long long*)(F.lds + TBL_OFF);
#pragma unroll
        for (int i = 0; i < 24; ++i) t[i] = (unsigned long long)args.in[i]; }
    __syncthreads();
#if MK_ONE_LAUNCH
    XcdBarrier bar = xcd_barrier_post((unsigned*)(F.ctl + CW_BAR), F.MISC + 8);
#define GRID_BAR() xcd_barrier(bar)
#else
#define GRID_BAR() do {} while (0)
#endif
    const int lo = args.ph_lo, hi = args.ph_hi;
#define IN(k) (lo <= (k) && (k) < hi)
#define SEAM(k) do { if (IN(k) && IN((k) + 1)) GRID_BAR(); } while (0)
    const int gw = F.vcu * NWAVES + F.wave, NGW = F.G * NWAVES;

    if (IN(PH_P0) && (PHMASK & 1)) {
        for (int it = blockIdx.x; it < DEPTH * (NMOD / 64); it += F.G) skinny_item<0>(F, it / (NMOD / 64), it % (NMOD / 64));
        p0_transposes(F);
    }
    SEAM(PH_P0);
    if (IN(PH_P1) && (PHMASK & 2)) {
        constexpr int NB1 = NINP / 64, NB2 = DFF / 64;
        for (int it = blockIdx.x; it < DEPTH * (NB1 + NB2); it += F.G) { const int l = it / (NB1 + NB2), r = it % (NB1 + NB2);
            if (r < NB1) skinny_item<1>(F, l, r); else skinny_item<2>(F, l, r - NB1); }
        for (int m = gw; m < MTOK; m += NGW) xn0_row(F, m);
    }
    SEAM(PH_P1);
    float* MOD = (float*)(F.ws + WS_MOD);
    { constexpr int l = 0;
        const int pb = PH_L0 + l * PH_PER_LAYER;
        float* modl = MOD + (size_t)l * NSEQ * NMOD;
        if (IN(pb + 0) && (PHMASK & 4)) {
            pg8::Gemm g{(const bf16*)(F.ws + WS_XN), (const bf16*)(F.ws + WS_WIN) + (size_t)l * NINP * DM, MTOK, NINP, DM}; pg8::StaticOrder S; S.init(MTOK, NINP, F.G, (int)blockIdx.x);
            pg8::EpiProj E{(bf16*)(F.ws + WS_PROJ), (float*)(F.ws + WS_RA), (const float*)(F.ws + WS_ROWSQ), (const float*)(F.ws + WS_BIASM) + (size_t)l * NSEQ * NINP};
            pg8::gemm_phase<pg8::EpiProj, pg8::StaticOrder, true, true>(F.lds + RING_OFF, g, S, E);
        }
        SEAM(pb + 0);
        if (IN(pb + 1) && (PHMASK & 8)) {
#if FAST_ATTN
            mix1_phase<FAST_GLA ? 1152 : 0>(F, l);
#else
            attn_simple<1>(F, l); attn_simple<0>(F, l); cache_out_simple(F, l);
#endif
        }
        SEAM(pb + 1);
        if (IN(pb + 2) && (PHMASK & 16)) {
#if FAST_GLA
            gla_scan(F, l);
#else
            gla_simple(F, l);
#endif
        }
        SEAM(pb + 2);
        if (IN(pb + 3) && (PHMASK & 32)) {
#if FAST_GLA
            gla_out_phase(F, l);
#else
            gla_norm_simple(F, l);
#endif
        }
        SEAM(pb + 3);
        if (IN(pb + 4) && (PHMASK & 64)) {
            pg8::Gemm g{(const bf16*)(F.ws + WS_MIXED), (const bf16*)(F.ws + WS_WOUT) + (size_t)l * DM * DM, MTOK, DM, DM}; pg8::StaticOrder S; S.init(MTOK, DM, F.G, (int)blockIdx.x);
            pg8::EpiRes E{l == 0 ? INP(IN_XP) : F.out, l == 0 ? INP(IN_XS) : F.out + (size_t)NTP * DM, F.out, modl + 2048,
                          INP(IN_GMLP) + (size_t)l * DM, modl + 4096, (bf16*)(F.ws + WS_XN), (float*)(F.ws + WS_ROWSQ)};
            pg8::gemm_phase<pg8::EpiRes, pg8::StaticOrder, true, true>(F.lds + RING_OFF, g, S, E);
        }
        SEAM(pb + 4);
        if (IN(pb + 5) && (PHMASK & 128)) {
            pg8::Gemm g{(const bf16*)(F.ws + WS_XN), (const bf16*)(F.ws + WS_WUP) + (size_t)l * DFF * DM, MTOK, DFF, DM}; pg8::StaticOrder S; S.init(MTOK, DFF, F.G, (int)blockIdx.x);
            pg8::EpiUp E{(bf16*)(F.ws + WS_H), (const float*)(F.ws + WS_ROWSQ), (const float*)(F.ws + WS_BIASF) + (size_t)l * NSEQ * DFF};
            pg8::gemm_phase<pg8::EpiUp, pg8::StaticOrder, true, true>(F.lds + RING_OFF, g, S, E);
        }
        SEAM(pb + 5);
        if (IN(pb + 6) && (PHMASK & 256)) {
            pg8::Gemm g{(const bf16*)(F.ws + WS_H), (const bf16*)(F.ws + WS_WDN) + (size_t)l * DM * DFF, MTOK, DM, DFF}; pg8::StaticOrder S; S.init(MTOK, DM, F.G, (int)blockIdx.x);
            const bool more = (l + 1 < DEPTH);
            pg8::EpiRes E{F.out, F.out + (size_t)NTP * DM, F.out, modl + 5120,
                          more ? INP(IN_GMIX) + (size_t)(l + 1) * DM : nullptr, MOD + (size_t)(l + 1 < DEPTH ? l + 1 : l) * NSEQ * NMOD + 1024, (bf16*)(F.ws + WS_XN), (float*)(F.ws + WS_ROWSQ)};
            pg8::gemm_phase<pg8::EpiRes, pg8::StaticOrder, true, true>(F.lds + RING_OFF, g, S, E);
        }
        SEAM(pb + 6);
        }
    { constexpr int l = 1;
        const int pb = PH_L0 + l * PH_PER_LAYER;
        float* modl = MOD + (size_t)l * NSEQ * NMOD;
        if (IN(pb + 0) && (PHMASK & 4)) {
            pg8::Gemm g{(const bf16*)(F.ws + WS_XN), (const bf16*)(F.ws + WS_WIN) + (size_t)l * NINP * DM, MTOK, NINP, DM}; pg8::StaticOrder S; S.init(MTOK, NINP, F.G, (int)blockIdx.x);
            pg8::EpiProj E{(bf16*)(F.ws + WS_PROJ), (float*)(F.ws + WS_RA), (const float*)(F.ws + WS_ROWSQ), (const float*)(F.ws + WS_BIASM) + (size_t)l * NSEQ * NINP};
            pg8::gemm_phase<pg8::EpiProj, pg8::StaticOrder, true, true>(F.lds + RING_OFF, g, S, E);
        }
        SEAM(pb + 0);
        if (IN(pb + 1) && (PHMASK & 8)) {
#if FAST_ATTN
            mix1_phase<FAST_GLA ? 1152 : 0>(F, l);
#else
            attn_simple<1>(F, l); attn_simple<0>(F, l); cache_out_simple(F, l);
#endif
        }
        SEAM(pb + 1);
        if (IN(pb + 2) && (PHMASK & 16)) {
#if FAST_GLA
            gla_scan(F, l);
#else
            gla_simple(F, l);
#endif
        }
        SEAM(pb + 2);
        if (IN(pb + 3) && (PHMASK & 32)) {
#if FAST_GLA
            gla_out_phase(F, l);
#else
            gla_norm_simple(F, l);
#endif
        }
        SEAM(pb + 3);
        if (IN(pb + 4) && (PHMASK & 64)) {
            pg8::Gemm g{(const bf16*)(F.ws + WS_MIXED), (const bf16*)(F.ws + WS_WOUT) + (size_t)l * DM * DM, MTOK, DM, DM}; pg8::StaticOrder S; S.init(MTOK, DM, F.G, (int)blockIdx.x);
            pg8::EpiRes E{l == 0 ? INP(IN_XP) : F.out, l == 0 ? INP(IN_XS) : F.out + (size_t)NTP * DM, F.out, modl + 2048,
                          INP(IN_GMLP) + (size_t)l * DM, modl + 4096, (bf16*)(F.ws + WS_XN), (float*)(F.ws + WS_ROWSQ)};
            pg8::gemm_phase<pg8::EpiRes, pg8::StaticOrder, true, true>(F.lds + RING_OFF, g, S, E);
        }
        SEAM(pb + 4);
        if (IN(pb + 5) && (PHMASK & 128)) {
            pg8::Gemm g{(const bf16*)(F.ws + WS_XN), (const bf16*)(F.ws + WS_WUP) + (size_t)l * DFF * DM, MTOK, DFF, DM}; pg8::StaticOrder S; S.init(MTOK, DFF, F.G, (int)blockIdx.x);
            pg8::EpiUp E{(bf16*)(F.ws + WS_H), (const float*)(F.ws + WS_ROWSQ), (const float*)(F.ws + WS_BIASF) + (size_t)l * NSEQ * DFF};
            pg8::gemm_phase<pg8::EpiUp, pg8::StaticOrder, true, true>(F.lds + RING_OFF, g, S, E);
        }
        SEAM(pb + 5);
        if (IN(pb + 6) && (PHMASK & 256)) {
            pg8::Gemm g{(const bf16*)(F.ws + WS_H), (const bf16*)(F.ws + WS_WDN) + (size_t)l * DM * DFF, MTOK, DM, DFF}; pg8::StaticOrder S; S.init(MTOK, DM, F.G, (int)blockIdx.x);
            const bool more = (l + 1 < DEPTH);
            pg8::EpiRes E{F.out, F.out + (size_t)NTP * DM, F.out, modl + 5120,
                          more ? INP(IN_GMIX) + (size_t)(l + 1) * DM : nullptr, MOD + (size_t)(l + 1 < DEPTH ? l + 1 : l) * NSEQ * NMOD + 1024, (bf16*)(F.ws + WS_XN), (float*)(F.ws + WS_ROWSQ)};
            pg8::gemm_phase<pg8::EpiRes, pg8::StaticOrder, true, true>(F.lds + RING_OFF, g, S, E);
        }
        SEAM(pb + 6);
        }
    if (IN(PH_FINAL) && (PHMASK & 512)) { for (int m = gw; m < MTOK; m += NGW) final_row(F, m); }
#undef IN
#undef SEAM
}

extern "C" void kernel_launch(void* const* d_in, const int* in_sizes, int n_in, void* d_out, int out_size, void* d_ws, size_t ws_size, hipStream_t stream) {
    static int grid = 0;
    if (grid == 0) {
        if (n_in != 24 || out_size != (int)O_END || ws_size < WS_END) { fprintf(stderr, "kernel_launch: unexpected shapes: n_in %d out %d ws %zu\n", n_in, out_size, ws_size); grid = -1; return; }
        int dev = 0, cus = 0, per_cu = 0;
        if (hipGetDevice(&dev) != hipSuccess || hipDeviceGetAttribute(&cus, hipDeviceAttributeMultiprocessorCount, dev) != hipSuccess) { grid = -1; return; }
        if (hipFuncSetAttribute((const void*)enc_fwd, hipFuncAttributeMaxDynamicSharedMemorySize, LDS_BYTES) != hipSuccess) { fprintf(stderr, "kernel_launch: hipFuncSetAttribute failed\n"); grid = -1; return; }
        if (hipOccupancyMaxActiveBlocksPerMultiprocessor(&per_cu, (const void*)enc_fwd, NWAVES * 64, LDS_BYTES) != hipSuccess || per_cu < 1) { fprintf(stderr, "kernel_launch: occupancy query says %d\n", per_cu); (void)hipGetLastError(); per_cu = 1; }
        grid = cus;
    }
    if (grid < 0) return;
    (void)hipMemsetAsync((char*)d_ws + WS_CTL, 0, CTL_ZERO_BYTES, stream);
    Args a{};
    for (int i = 0; i < 24; ++i) a.in[i] = (const float*)d_in[i];
    a.out = (float*)d_out; a.ws = (unsigned char*)d_ws;
#if MK_ONE_LAUNCH
    a.ph_lo = 0; a.ph_hi = N_PHASES;
    hipLaunchKernelGGL(enc_fwd, dim3(grid), dim3(NWAVES * 64), LDS_BYTES, stream, a);
#else
    for (int p = 0; p < N_PHASES; ++p) { a.ph_lo = p; a.ph_hi = p + 1; hipLaunchKernelGGL(enc_fwd, dim3(grid), dim3(NWAVES * 64), LDS_BYTES, stream, a); }
#endif
}
```

```cpp
#include <hip/hip_runtime.h>
#include <cstdio>
#include <cstdint>
namespace pg8 {
#define PG8_LAS __attribute__((address_space(3)))
typedef unsigned short bf16_t;
typedef short bf16x8 __attribute__((ext_vector_type(8)));
typedef float f32x4 __attribute__((ext_vector_type(4)));
typedef unsigned u32x4 __attribute__((ext_vector_type(4)));
typedef unsigned u32x2 __attribute__((ext_vector_type(2)));
constexpr int BM = 256, BK = 64, HALF = 128, HTB = HALF * BK * 2  , STAGE_BYTES = 8 * HTB, NXCD = 8, WGM = 8;

__host__ __device__ __forceinline__ int lds_byte(int r, int c) { const int st = (r >> 4) * 2 + (c >> 5), rr = r & 15, cc = c & 31, ob = rr * 64 + cc * 2; return st * 1024 + (ob ^ (((ob >> 9) & 1) << 5)); }
__host__ __device__ __forceinline__ void stage_rc(int b, int& R, int& C) { const int st = b / 1024, sb = b % 1024, swz = sb ^ (((sb >> 9) & 1) << 5); R = (st >> 1) * 16 + swz / 64; C = (st & 1) * 32 + (swz % 64) / 2; }
__host__ __device__ __forceinline__ int perm32(int rho) { const int n = rho >> 4, i = rho & 15; return 8 * (i >> 2) + 4 * n + (i & 3); }

struct Unit { int pm, pn; };
struct Gemm { const bf16_t* A; const bf16_t* Bt; int M, N, K; };

struct StaticOrder {
    int nM, nN, nwg, G, c;
    __host__ __device__ void init(int M, int N, int G_, int c_) { nM = M / BM; nN = N / BM; nwg = nM * nN; G = G_; c = c_; }
    __host__ __device__ bool next(int i, Unit& u) const {
        const long L = (long)i * G + c; if (L >= nwg) return false;
        int wgid = (int)L; { const int q = nwg / NXCD, r = nwg % NXCD, xcd = wgid % NXCD, off = wgid / NXCD; wgid = (xcd < r ? xcd * (q + 1) : r * (q + 1) + (xcd - r) * q) + off; }
        const int nig = WGM * nN, gid = wgid / nig, fm = gid * WGM, gsz = (nM - fm) < WGM ? (nM - fm) : WGM;
        u.pm = fm + ((wgid % nig) % gsz); u.pn = (wgid % nig) / gsz; return true;
    }
    __device__ __forceinline__ void a_ready(const Unit&) const {}
    __device__ __forceinline__ void done(const Unit&) const {}
};

__device__ __forceinline__ unsigned cvt_pk_bf16(float lo, float hi) { unsigned r; asm volatile("v_cvt_pk_bf16_f32 %0, %1, %2" : "=v"(r) : "v"(lo), "v"(hi)); return r; }

constexpr int NTOK_P = 16384, D_MODEL = 1024, PLD = 2816, NMOD = 6144, NIN_PAD = 3072, DFF = 4096;
constexpr float NEPS = 1e-6f;
__device__ __forceinline__ int seq_of_row(int r) { return r < NTOK_P ? 0 : 1 + ((r - NTOK_P) >> 6); }
__device__ __forceinline__ float rstd_of(const float* rsq) {
    const f32x4 a = *(const f32x4*)rsq, b = *(const f32x4*)(rsq + 4), c = *(const f32x4*)(rsq + 8), d = *(const f32x4*)(rsq + 12);
    const float s = ((a[0] + a[1]) + (a[2] + a[3])) + ((b[0] + b[1]) + (b[2] + b[3])) + ((c[0] + c[1]) + (c[2] + c[3])) + ((d[0] + d[1]) + (d[2] + d[3]));
    return 1.0f / sqrtf(s * (1.0f / D_MODEL) + NEPS);
}


struct EpiProj {
    static constexpr bool PERM = true, AFTER_DRAIN = false;
    bf16_t* proj; float* ra; const float* rowsq; const float* bias;
    __device__ __forceinline__ void operator()(const f32x4 (&acc)[2][2][4][2], const Unit& u, int wr, int wc, int fr, int fq) const {
#pragma unroll
        for (int ai = 0; ai < 2; ++ai) {
            const int rowb = u.pm * BM + ai * HALF + wr * 64; const int s = seq_of_row(rowb);
            const int colt = u.pn * BM + wc * 32 + 8 * fq;
            const float* bs = bias + (size_t)s * NIN_PAD + colt;
            f32x4 bv[2][2];
#pragma unroll
            for (int bj = 0; bj < 2; ++bj)
#pragma unroll
                for (int n = 0; n < 2; ++n) bv[bj][n] = *(const f32x4*)(bs + bj * HALF + 4 * n);
#pragma unroll
            for (int m = 0; m < 4; ++m) { const int r = rowb + m * 16 + fr; const float rs = rstd_of(rowsq + (size_t)r * 16);
#pragma unroll
                for (int bj = 0; bj < 2; ++bj) { const f32x4 v0 = acc[ai][bj][m][0] * rs + bv[bj][0], v1 = acc[ai][bj][m][1] * rs + bv[bj][1];
                    if (u.pn < 11) { u32x4 w; w.x = cvt_pk_bf16(v0[0], v0[1]); w.y = cvt_pk_bf16(v0[2], v0[3]); w.z = cvt_pk_bf16(v1[0], v1[1]); w.w = cvt_pk_bf16(v1[2], v1[3]);
                        *(u32x4*)(proj + (size_t)r * PLD + colt + bj * HALF) = w; }
                    else if (bj == 0 && wc == 0 && fq < 2) { *(f32x4*)(ra + (size_t)r * 16 + 8 * fq) = v0; *(f32x4*)(ra + (size_t)r * 16 + 8 * fq + 4) = v1; } } }
        }
    }
};
struct EpiUp {
    static constexpr bool PERM = true, AFTER_DRAIN = false;
    bf16_t* H; const float* rowsq; const float* bias;
    __device__ __forceinline__ void operator()(const f32x4 (&acc)[2][2][4][2], const Unit& u, int wr, int wc, int fr, int fq) const {
#pragma unroll
        for (int ai = 0; ai < 2; ++ai) {
            const int rowb = u.pm * BM + ai * HALF + wr * 64; const int s = seq_of_row(rowb);
            const int colt = u.pn * BM + wc * 32 + 8 * fq;
            const float* bs = bias + (size_t)s * DFF + colt;
            f32x4 bv[2][2];
#pragma unroll
            for (int bj = 0; bj < 2; ++bj)
#pragma unroll
                for (int n = 0; n < 2; ++n) bv[bj][n] = *(const f32x4*)(bs + bj * HALF + 4 * n);
#pragma unroll
            for (int m = 0; m < 4; ++m) { const int r = rowb + m * 16 + fr; const float rs = rstd_of(rowsq + (size_t)r * 16);
#pragma unroll
                for (int bj = 0; bj < 2; ++bj) { f32x4 v0 = acc[ai][bj][m][0] * rs + bv[bj][0], v1 = acc[ai][bj][m][1] * rs + bv[bj][1];
#pragma unroll
                    for (int e = 0; e < 4; ++e) { const float a = fmaxf(v0[e], 0.f), b = fmaxf(v1[e], 0.f); v0[e] = a * a; v1[e] = b * b; }
                    u32x4 w; w.x = cvt_pk_bf16(v0[0], v0[1]); w.y = cvt_pk_bf16(v0[2], v0[3]); w.z = cvt_pk_bf16(v1[0], v1[1]); w.w = cvt_pk_bf16(v1[2], v1[3]);
                    *(u32x4*)(H + (size_t)r * DFF + colt + bj * HALF) = w; } }
        }
    }
};
struct EpiRes {
    static constexpr bool PERM = false, AFTER_DRAIN = false;
    const float* basep; const float* bases; float* out; const float* gate;
    const float* gn; const float* scn; bf16_t* xn; float* rowsq;
    __device__ __forceinline__ void operator()(const f32x4 (&acc)[2][2][4][2], const Unit& u, int wr, int wc, int fr, int fq) const {
#pragma unroll
        for (int ai = 0; ai < 2; ++ai) {
            const int rowb = u.pm * BM + ai * HALF + wr * 64; const int s = seq_of_row(rowb);
            const int colt = u.pn * BM + wc * 32 + 4 * fq;
            f32x4 gv[2][2], wv[2][2];
#pragma unroll
            for (int bj = 0; bj < 2; ++bj)
#pragma unroll
                for (int n = 0; n < 2; ++n) { const int c = colt + bj * HALF + 16 * n; gv[bj][n] = *(const f32x4*)(gate + (size_t)s * NMOD + c);
                    if (gn) { const f32x4 g = *(const f32x4*)(gn + c), sc = *(const f32x4*)(scn + (size_t)s * NMOD + c); wv[bj][n] = g * (sc + 1.0f); } else wv[bj][n] = (f32x4){0.f, 0.f, 0.f, 0.f}; }
#pragma unroll
            for (int m = 0; m < 4; ++m) { const int r = rowb + m * 16 + fr;
                const float* bp = (r < NTOK_P) ? basep + (size_t)r * D_MODEL : bases + (size_t)(r - NTOK_P) * D_MODEL;
                float ss = 0.f;
#pragma unroll
                for (int bj = 0; bj < 2; ++bj)
#pragma unroll
                    for (int n = 0; n < 2; ++n) { const int c = colt + bj * HALF + 16 * n;
                        const f32x4 bsv = *(const f32x4*)(bp + c); const f32x4 x1 = bsv + gv[bj][n] * acc[ai][bj][m][n];
                        *(f32x4*)(out + (size_t)r * D_MODEL + c) = x1;
                        ss += (x1[0] * x1[0] + x1[1] * x1[1]) + (x1[2] * x1[2] + x1[3] * x1[3]);
                        if (gn) { const f32x4 y = x1 * wv[bj][n]; u32x2 w; w.x = cvt_pk_bf16(y[0], y[1]); w.y = cvt_pk_bf16(y[2], y[3]); *(u32x2*)(xn + (size_t)r * D_MODEL + c) = w; } }
                ss += __shfl_xor(ss, 16); ss += __shfl_xor(ss, 32);
                if (fq == 0) rowsq[(size_t)r * 16 + u.pn * 4 + wc] = ss;
            }
        }
    }
};

__device__ __forceinline__ float rstd_of4(const float* rsq, int fq) {
    const f32x4 a = *(const f32x4*)(rsq + 4 * fq); float s = (a[0] + a[1]) + (a[2] + a[3]);
    s += __shfl_xor(s, 16); s += __shfl_xor(s, 32);
    return 1.0f / sqrtf(s * (1.0f / D_MODEL) + NEPS);
}
struct EpiProj3 {
    static constexpr bool PERM = true;
    bf16_t* proj; float* ra; const float* rowsq; const float* bias;
    __device__ __forceinline__ void operator()(const f32x4 (&acc)[3][2][3][2], const Unit& u, int wr, int wc, int fr, int fq) const {
        const int colt = u.pn * BM + wc * 32 + 8 * fq;
#pragma unroll
        for (int ai = 0; ai < 3; ++ai)
#pragma unroll
            for (int m = 0; m < 3; ++m) {
                const int rowg = u.pm * 288 + ai * 96 + wr * 48 + m * 16; const int s = seq_of_row(rowg); const int r = rowg + fr;
                const float rs = rstd_of4(rowsq + (size_t)r * 16, fq);
                const float* bs = bias + (size_t)s * NIN_PAD + colt;
#pragma unroll
                for (int bj = 0; bj < 2; ++bj) { const f32x4 b0 = *(const f32x4*)(bs + bj * HALF), b1 = *(const f32x4*)(bs + bj * HALF + 4);
                    const f32x4 v0 = acc[ai][bj][m][0] * rs + b0, v1 = acc[ai][bj][m][1] * rs + b1;
                    if (u.pn < 11) { u32x4 w; w.x = cvt_pk_bf16(v0[0], v0[1]); w.y = cvt_pk_bf16(v0[2], v0[3]); w.z = cvt_pk_bf16(v1[0], v1[1]); w.w = cvt_pk_bf16(v1[2], v1[3]);
                        *(u32x4*)(proj + (size_t)r * PLD + colt + bj * HALF) = w; }
                    else if (bj == 0 && wc == 0 && fq < 2) { *(f32x4*)(ra + (size_t)r * 16 + 8 * fq) = v0; *(f32x4*)(ra + (size_t)r * 16 + 8 * fq + 4) = v1; } }
                asm volatile("" ::: "memory");
            }
    }
};
struct EpiUp3 {
    static constexpr bool PERM = true;
    bf16_t* H; const float* rowsq; const float* bias;
    __device__ __forceinline__ void operator()(const f32x4 (&acc)[3][2][3][2], const Unit& u, int wr, int wc, int fr, int fq) const {
        const int colt = u.pn * BM + wc * 32 + 8 * fq;
#pragma unroll
        for (int ai = 0; ai < 3; ++ai)
#pragma unroll
            for (int m = 0; m < 3; ++m) {
                const int rowg = u.pm * 288 + ai * 96 + wr * 48 + m * 16; const int s = seq_of_row(rowg); const int r = rowg + fr;
                const float rs = rstd_of4(rowsq + (size_t)r * 16, fq);
                const float* bs = bias + (size_t)s * DFF + colt;
#pragma unroll
                for (int bj = 0; bj < 2; ++bj) { const f32x4 b0 = *(const f32x4*)(bs + bj * HALF), b1 = *(const f32x4*)(bs + bj * HALF + 4);
                    f32x4 v0 = acc[ai][bj][m][0] * rs + b0, v1 = acc[ai][bj][m][1] * rs + b1;
#pragma unroll
                    for (int e = 0; e < 4; ++e) { const float a = fmaxf(v0[e], 0.f), b = fmaxf(v1[e], 0.f); v0[e] = a * a; v1[e] = b * b; }
                    u32x4 w; w.x = cvt_pk_bf16(v0[0], v0[1]); w.y = cvt_pk_bf16(v0[2], v0[3]); w.z = cvt_pk_bf16(v1[0], v1[1]); w.w = cvt_pk_bf16(v1[2], v1[3]);
                    *(u32x4*)(H + (size_t)r * DFF + colt + bj * HALF) = w; }
                asm volatile("" ::: "memory");
            }
    }
};
struct EpiRes3 {
    static constexpr bool PERM = false;
    const float* basep; const float* bases; float* out; const float* gate; const float* gn; const float* scn; bf16_t* xn; float* rowsq;
    __device__ __forceinline__ void operator()(const f32x4 (&acc)[3][2][3][2], const Unit& u, int wr, int wc, int fr, int fq) const {
        const int colt = u.pn * BM + wc * 32 + 4 * fq;
#pragma unroll
        for (int ai = 0; ai < 3; ++ai)
#pragma unroll
            for (int m = 0; m < 3; ++m) {
                const int rowg = u.pm * 288 + ai * 96 + wr * 48 + m * 16; const int s = seq_of_row(rowg); const int r = rowg + fr;
                const float* bp = (r < NTOK_P) ? basep + (size_t)r * D_MODEL : bases + (size_t)(r - NTOK_P) * D_MODEL;
                float ss = 0.f;
#pragma unroll
                for (int bj = 0; bj < 2; ++bj)
#pragma unroll
                    for (int n = 0; n < 2; ++n) { const int c = colt + bj * HALF + 16 * n;
                        const f32x4 gv = *(const f32x4*)(gate + (size_t)s * NMOD + c);
                        const f32x4 bsv = *(const f32x4*)(bp + c); const f32x4 x1 = bsv + gv * acc[ai][bj][m][n];
                        *(f32x4*)(out + (size_t)r * D_MODEL + c) = x1;
                        ss += (x1[0] * x1[0] + x1[1] * x1[1]) + (x1[2] * x1[2] + x1[3] * x1[3]);
                        if (gn) { const f32x4 g4 = *(const f32x4*)(gn + c), sc = *(const f32x4*)(scn + (size_t)s * NMOD + c); const f32x4 y = x1 * (g4 * (sc + 1.0f));
                            u32x2 w; w.x = cvt_pk_bf16(y[0], y[1]); w.y = cvt_pk_bf16(y[2], y[3]); *(u32x2*)(xn + (size_t)r * D_MODEL + c) = w; } }
                ss += __shfl_xor(ss, 16); ss += __shfl_xor(ss, 32);
                if (fq == 0) rowsq[(size_t)r * 16 + u.pn * 4 + wc] = ss;
                asm volatile("" ::: "memory");
            }
    }
};
template <class Epi, class Sched, bool ALIGN_EPI = false, bool SP2 = false>
__device__ __forceinline__ void gemm_phase(PG8_LAS unsigned char* lds, const Gemm g, const Sched& S, const Epi& E) {
    const int tid = threadIdx.x, wid = __builtin_amdgcn_readfirstlane(tid >> 6), lane = tid & 63, wr = wid >> 2, wc = wid & 3, fr = lane & 15, fq = lane >> 4;
    const int K = g.K, nt = K / BK;
    unsigned voffA[2], voffB[2];
#pragma unroll
    for (int i = 0; i < 2; ++i) { int R, C; stage_rc(tid * 16 + i * 8192, R, C); const int Rb = Epi::PERM ? ((R & ~31) + perm32(R & 31)) : R;
        voffA[i] = (unsigned)(R * K + C) * 2u; voffB[i] = (unsigned)(Rb * K + C) * 2u; }
    const size_t kstep = (size_t)(BK * 2);
    const size_t hstep = (size_t)HALF * K * 2;
    const size_t tstep = 2 * hstep;
    const unsigned ldsw = (unsigned)wid * 1024u;
    const int aoff = lds_byte(wr * 64 + fr, fq * 8), boff = lds_byte(wc * 32 + fr, fq * 8);
#define PG8_SA(b, h) (((b) * 2 + (h)) * HTB)
#define PG8_SB(b, h) ((4 + (b) * 2 + (h)) * HTB)
#define PG8_STAGE(bufoff, gbase, voff) do { _Pragma("unroll") for (int _i = 0; _i < 2; ++_i) \
        __builtin_amdgcn_global_load_lds((const unsigned*)((const char*)(gbase) + (voff)[_i]), (PG8_LAS unsigned*)(lds + (bufoff) + ldsw + _i * 8192), 16, 0, 0); } while (0)
#define PG8_LDA(dst, b, h) do { _Pragma("unroll") for (int m = 0; m < 4; ++m) _Pragma("unroll") for (int k = 0; k < 2; ++k) dst[m][k] = *(const PG8_LAS bf16x8*)(lds + PG8_SA(b, h) + aoff + m * 2048 + k * 1024); } while (0)
#define PG8_LDB(dst, b, h) do { _Pragma("unroll") for (int n = 0; n < 2; ++n) _Pragma("unroll") for (int k = 0; k < 2; ++k) dst[n][k] = *(const PG8_LAS bf16x8*)(lds + PG8_SB(b, h) + boff + n * 2048 + k * 1024); } while (0)
#define PG8_MMA(ai, bj, At, Bt) do { __builtin_amdgcn_s_setprio(1); _Pragma("unroll") for (int m = 0; m < 4; ++m) _Pragma("unroll") for (int n = 0; n < 2; ++n) _Pragma("unroll") for (int k = 0; k < 2; ++k) \
        acc[ai][bj][m][n] = __builtin_amdgcn_mfma_f32_16x16x32_bf16(Bt[n][k], At[m][k], acc[ai][bj][m][n], 0, 0, 0); __builtin_amdgcn_s_setprio(0); } while (0)
#define PG8_WAIT_V(n) asm volatile("s_waitcnt vmcnt(" #n ")" ::: "memory")
#define PG8_WAIT_L(n) asm volatile("s_waitcnt lgkmcnt(" #n ")" ::: "memory")
#define PG8_BAR __builtin_amdgcn_s_barrier()
#define PG8_SCHED __builtin_amdgcn_sched_barrier(0)
    Unit cur, nxt; int ui = 0;
    if (!S.next(0, cur)) return;
    f32x4 acc[2][2][4][2];
#pragma unroll
    for (int a = 0; a < 2; ++a)
#pragma unroll
        for (int b = 0; b < 2; ++b)
#pragma unroll
            for (int m = 0; m < 4; ++m)
#pragma unroll
                for (int n = 0; n < 2; ++n) acc[a][b][m][n] = (f32x4){0.f, 0.f, 0.f, 0.f};
    bf16x8 At[4][2], B0[2][2], B1[2][2];
    const char* cA = (const char*)g.A + (size_t)cur.pm * tstep; const char* cB = (const char*)g.Bt + (size_t)cur.pn * tstep;
    S.a_ready(cur);
    if constexpr (SP2) {
        PG8_STAGE(PG8_SB(0, 0), cB, voffB); PG8_STAGE(PG8_SB(0, 1), cB + hstep, voffB); PG8_STAGE(PG8_SA(0, 0), cA, voffA); PG8_STAGE(PG8_SA(0, 1), cA + hstep, voffA);
        if (wr == 1) PG8_BAR;
        PG8_WAIT_V(2); PG8_BAR;
        PG8_STAGE(PG8_SB(1, 0), cB + kstep, voffB); PG8_STAGE(PG8_SA(1, 0), cA + kstep, voffA); PG8_STAGE(PG8_SB(1, 1), cB + hstep + kstep, voffB);
        PG8_WAIT_V(6); PG8_BAR;
    } else {
        PG8_STAGE(PG8_SB(0, 0), cB, voffB); PG8_STAGE(PG8_SA(0, 0), cA, voffA); PG8_STAGE(PG8_SB(0, 1), cB + hstep, voffB); PG8_STAGE(PG8_SA(0, 1), cA + hstep, voffA);
        if (wr == 1) PG8_BAR;
        PG8_WAIT_V(4); PG8_BAR;
        PG8_STAGE(PG8_SB(1, 0), cB + kstep, voffB); PG8_STAGE(PG8_SA(1, 0), cA + kstep, voffA); PG8_STAGE(PG8_SB(1, 1), cB + hstep + kstep, voffB);
        PG8_WAIT_V(6); PG8_BAR;
    }
    for (;;) {
        const bool has_next = S.next(ui + 1, nxt);
        const char* nA = has_next ? (const char*)g.A + (size_t)nxt.pm * tstep : cA; const char* nB = has_next ? (const char*)g.Bt + (size_t)nxt.pn * tstep : cB;
        for (int t = 0; t < nt; t += 2) {
            const bool last = (t == nt - 2);
            const char* a1 = cA + (size_t)(t + 1) * kstep;
            const char* a2 = last ? nA : cA + (size_t)(t + 2) * kstep; const char* b2 = last ? nB : cB + (size_t)(t + 2) * kstep;
            const char* a3 = a2 + kstep; const char* b3 = b2 + kstep;
            if (last && has_next) S.a_ready(nxt);
            if constexpr (SP2) {
            PG8_LDB(B0, 0, 0); PG8_LDB(B1, 0, 1); PG8_SCHED; PG8_LDA(At, 0, 0); PG8_STAGE(PG8_SA(1, 1), a1 + hstep, voffA);
            PG8_WAIT_V(8); PG8_WAIT_L(0); PG8_BAR; PG8_MMA(0, 0, At, B0); PG8_MMA(0, 1, At, B1); PG8_BAR; PG8_SCHED;
            PG8_LDA(At, 0, 1); PG8_STAGE(PG8_SB(0, 0), b2, voffB); PG8_STAGE(PG8_SB(0, 1), b2 + hstep, voffB); PG8_STAGE(PG8_SA(0, 0), a2, voffA);
            PG8_WAIT_V(8); PG8_WAIT_L(0); PG8_BAR; PG8_MMA(1, 0, At, B0); PG8_MMA(1, 1, At, B1); PG8_BAR; PG8_SCHED;
            PG8_LDB(B0, 1, 0); PG8_LDB(B1, 1, 1); PG8_SCHED; PG8_LDA(At, 1, 0); PG8_STAGE(PG8_SA(0, 1), a2 + hstep, voffA);
            PG8_WAIT_V(8); PG8_WAIT_L(0); PG8_BAR; PG8_MMA(0, 0, At, B0); PG8_MMA(0, 1, At, B1); PG8_BAR; PG8_SCHED;
            PG8_LDA(At, 1, 1); PG8_STAGE(PG8_SB(1, 0), b3, voffB); PG8_STAGE(PG8_SB(1, 1), b3 + hstep, voffB); PG8_STAGE(PG8_SA(1, 0), a3, voffA);
            PG8_WAIT_V(8); PG8_WAIT_L(0); PG8_BAR; PG8_MMA(1, 0, At, B0); PG8_MMA(1, 1, At, B1); PG8_BAR; PG8_SCHED;
            } else {
            PG8_LDB(B0, 0, 0); PG8_SCHED; PG8_LDA(At, 0, 0); PG8_STAGE(PG8_SA(1, 1), a1 + hstep, voffA);
            PG8_WAIT_L(8); PG8_BAR; PG8_WAIT_L(0); PG8_MMA(0, 0, At, B0); PG8_BAR; PG8_SCHED;
            PG8_LDB(B1, 0, 1); PG8_STAGE(PG8_SB(0, 0), b2, voffB);
            PG8_BAR; PG8_WAIT_L(0); PG8_MMA(0, 1, At, B1); PG8_BAR;
            PG8_LDA(At, 0, 1); PG8_STAGE(PG8_SA(0, 0), a2, voffA);
            PG8_BAR; PG8_WAIT_L(0); PG8_MMA(1, 0, At, B0); PG8_BAR; PG8_SCHED;
            PG8_STAGE(PG8_SB(0, 1), b2 + hstep, voffB);
            PG8_WAIT_V(6); PG8_BAR; PG8_MMA(1, 1, At, B1); PG8_BAR;
            PG8_LDB(B0, 1, 0); PG8_SCHED; PG8_LDA(At, 1, 0); PG8_STAGE(PG8_SA(0, 1), a2 + hstep, voffA);
            PG8_WAIT_L(8); PG8_BAR; PG8_WAIT_L(0); PG8_MMA(0, 0, At, B0); PG8_BAR; PG8_SCHED;
            PG8_LDB(B1, 1, 1); PG8_STAGE(PG8_SB(1, 0), b3, voffB);
            PG8_BAR; PG8_WAIT_L(0); PG8_MMA(0, 1, At, B1); PG8_BAR;
            PG8_LDA(At, 1, 1); PG8_STAGE(PG8_SA(1, 0), a3, voffA);
            PG8_BAR; PG8_WAIT_L(0); PG8_MMA(1, 0, At, B0); PG8_BAR; PG8_SCHED;
            PG8_STAGE(PG8_SB(1, 1), b3 + hstep, voffB);
            PG8_WAIT_V(6); PG8_BAR; PG8_MMA(1, 1, At, B1); PG8_BAR;
            }
        }
        if constexpr (ALIGN_EPI) { if (wr == 0) PG8_BAR; }
        if constexpr (!Epi::AFTER_DRAIN) { E(acc, cur, wr, wc, fr, fq); S.done(cur); }
        if (!has_next) break;
#pragma unroll
        for (int a = 0; a < 2; ++a)
#pragma unroll
            for (int b = 0; b < 2; ++b)
#pragma unroll
                for (int m = 0; m < 4; ++m)
#pragma unroll
                    for (int n = 0; n < 2; ++n) acc[a][b][m][n] = (f32x4){0.f, 0.f, 0.f, 0.f};
        cur = nxt; cA = nA; cB = nB; ++ui;
        if constexpr (ALIGN_EPI) { if (wr == 1) PG8_BAR; }
    }
    PG8_WAIT_V(0);
    if constexpr (!ALIGN_EPI) { if (wr == 0) PG8_BAR; }
    PG8_BAR;
    if constexpr (Epi::AFTER_DRAIN) { E.fused(acc, cur, wr, wc, fr, fq, lds, wid, lane); S.done(cur); }
#undef PG8_SA
#undef PG8_SB
#undef PG8_STAGE
#undef PG8_LDA
#undef PG8_LDB
#undef PG8_MMA
#undef PG8_WAIT_V
#undef PG8_WAIT_L
#undef PG8_BAR
#undef PG8_SCHED
}
constexpr int BM3 = 288, THIRD = 96, TTB = THIRD * BK * 2  , STAGE3_BYTES = 6 * TTB + 4 * HTB  ;
struct Unit3 { int pm, pn; };
struct StaticOrder3 {
    int nM, nN, nwg, G, c;
    __host__ __device__ void init(int M, int N, int G_, int c_) { nM = M / BM3; nN = N / BM; nwg = nM * nN; G = G_; c = c_; }
    __host__ __device__ bool next(int i, Unit& u) const {
        const long L = (long)i * G + c; if (L >= nwg) return false;
        int wgid = (int)L; { const int q = nwg / NXCD, r = nwg % NXCD, xcd = wgid % NXCD, off = wgid / NXCD; wgid = (xcd < r ? xcd * (q + 1) : r * (q + 1) + (xcd - r) * q) + off; }
        const int nig = WGM * nN, gid = wgid / nig, fm = gid * WGM, gsz = (nM - fm) < WGM ? (nM - fm) : WGM;
        u.pm = fm + ((wgid % nig) % gsz); u.pn = (wgid % nig) / gsz; return true;
    }
};
template <class Epi, class Sched, bool ALIGN_EPI = true>
__device__ __forceinline__ void gemm_phase288(PG8_LAS unsigned char* lds, const Gemm g, const Sched& S, const Epi& E) {
    const int tid = threadIdx.x, wid = __builtin_amdgcn_readfirstlane(tid >> 6), lane = tid & 63, wr = wid >> 2, wc = wid & 3, fr = lane & 15, fq = lane >> 4;
    const int K = g.K, nt = K / BK;
    unsigned voffA[2], voffB[2];
    { int R, C; stage_rc(tid * 16, R, C); voffA[0] = (unsigned)(R * K + C) * 2u;
      stage_rc((8 + (wid & 3)) * 1024 + lane * 16, R, C); voffA[1] = (unsigned)(R * K + C) * 2u; }
#pragma unroll
    for (int i = 0; i < 2; ++i) { int R, C; stage_rc(tid * 16 + i * 8192, R, C); const int Rb = Epi::PERM ? ((R & ~31) + perm32(R & 31)) : R; voffB[i] = (unsigned)(Rb * K + C) * 2u; }
    const size_t kstep = (size_t)(BK * 2);
    const size_t hstep = (size_t)HALF * K * 2, tstepB = 2 * hstep;
    const size_t third = (size_t)THIRD * K * 2, tstepA = 3 * third;
    const unsigned ldsw = (unsigned)wid * 1024u, ldsx = (unsigned)(8 + (wid & 3)) * 1024u;
    const int aoff = lds_byte(wr * 48 + fr, fq * 8), boff = lds_byte(wc * 32 + fr, fq * 8);
#define P3_SA(b, j) (((b) * 3 + (j)) * TTB)
#define P3_SB(b, h) (6 * TTB + ((b) * 2 + (h)) * HTB)
#define P3_GLDS(gp, ldsoff) __builtin_amdgcn_global_load_lds((const unsigned*)(gp), (PG8_LAS unsigned*)(lds + (ldsoff)), 16, 0, 0)
#define P3_STAGE_B(bufoff, gbase) do { P3_GLDS((const char*)(gbase) + voffB[0], (bufoff) + ldsw); P3_GLDS((const char*)(gbase) + voffB[1], (bufoff) + ldsw + 8192); } while (0)
#define P3_STAGE_A(bufoff, gbase, grp) do { P3_GLDS((const char*)(gbase) + voffA[0], (bufoff) + ldsw); if (wr == (grp)) P3_GLDS((const char*)(gbase) + voffA[1], (bufoff) + ldsx); } while (0)
#define P3_LDA(dst, b, j) do { _Pragma("unroll") for (int m = 0; m < 3; ++m) _Pragma("unroll") for (int k = 0; k < 2; ++k) dst[m][k] = *(const PG8_LAS bf16x8*)(lds + P3_SA(b, j) + aoff + m * 2048 + k * 1024); } while (0)
#define P3_LDB(dst, b, h) do { _Pragma("unroll") for (int n = 0; n < 2; ++n) _Pragma("unroll") for (int k = 0; k < 2; ++k) dst[n][k] = *(const PG8_LAS bf16x8*)(lds + P3_SB(b, h) + boff + n * 2048 + k * 1024); } while (0)
#define P3_MMA(ai, bj, At, Bt) do { __builtin_amdgcn_s_setprio(1); _Pragma("unroll") for (int m = 0; m < 3; ++m) _Pragma("unroll") for (int n = 0; n < 2; ++n) _Pragma("unroll") for (int k = 0; k < 2; ++k) \
        acc[ai][bj][m][n] = __builtin_amdgcn_mfma_f32_16x16x32_bf16(Bt[n][k], At[m][k], acc[ai][bj][m][n], 0, 0, 0); __builtin_amdgcn_s_setprio(0); } while (0)
#define P3_WAIT_V(n) asm volatile("s_waitcnt vmcnt(" #n ")" ::: "memory")
#define P3_WAIT_L(n) asm volatile("s_waitcnt lgkmcnt(" #n ")" ::: "memory")
#define P3_BAR __builtin_amdgcn_s_barrier()
#define P3_SCHED __builtin_amdgcn_sched_barrier(0)
    Unit cur, nxt; int ui = 0;
    if (!S.next(0, cur)) return;
    f32x4 acc[3][2][3][2];
#pragma unroll
    for (int a = 0; a < 3; ++a)
#pragma unroll
        for (int b = 0; b < 2; ++b)
#pragma unroll
            for (int m = 0; m < 3; ++m)
#pragma unroll
                for (int n = 0; n < 2; ++n) acc[a][b][m][n] = (f32x4){0.f, 0.f, 0.f, 0.f};
    bf16x8 At[3][2], B0[2][2], B1[2][2];
    const char* cA = (const char*)g.A + (size_t)cur.pm * tstepA; const char* cB = (const char*)g.Bt + (size_t)cur.pn * tstepB;
    P3_STAGE_B(P3_SB(0, 0), cB); P3_STAGE_B(P3_SB(0, 1), cB + hstep); P3_STAGE_A(P3_SA(0, 0), cA, 0); P3_STAGE_A(P3_SA(0, 1), cA + third, 1); P3_STAGE_A(P3_SA(0, 2), cA + 2 * third, 0);
    if (wr == 1) P3_BAR;
    P3_WAIT_V(0); P3_BAR;
    P3_STAGE_B(P3_SB(1, 0), cB + kstep); P3_STAGE_B(P3_SB(1, 1), cB + hstep + kstep); P3_STAGE_A(P3_SA(1, 0), cA + kstep, 1); P3_STAGE_A(P3_SA(1, 1), cA + third + kstep, 0);
    P3_BAR;
    for (;;) {
        const bool has_next = S.next(ui + 1, nxt);
        const char* nA = has_next ? (const char*)g.A + (size_t)nxt.pm * tstepA : cA; const char* nB = has_next ? (const char*)g.Bt + (size_t)nxt.pn * tstepB : cB;
        for (int t = 0; t < nt; t += 2) {
            const bool last = (t == nt - 2);
            const char* a1 = cA + (size_t)(t + 1) * kstep;
            const char* a2 = last ? nA : cA + (size_t)(t + 2) * kstep; const char* b2 = last ? nB : cB + (size_t)(t + 2) * kstep;
            const char* a3 = a2 + kstep; const char* b3 = b2 + kstep;
            P3_LDB(B0, 0, 0); P3_LDB(B1, 0, 1); P3_SCHED; P3_LDA(At, 0, 0); P3_STAGE_A(P3_SA(1, 2), a1 + 2 * third, 1);
            P3_WAIT_V(8); P3_WAIT_L(0); P3_BAR; P3_MMA(0, 0, At, B0); P3_MMA(0, 1, At, B1); P3_BAR; P3_SCHED;
            P3_LDA(At, 0, 1); P3_STAGE_B(P3_SB(0, 0), b2); P3_STAGE_B(P3_SB(0, 1), b2 + hstep);
            P3_WAIT_V(8); P3_WAIT_L(0); P3_BAR; P3_MMA(1, 0, At, B0); P3_MMA(1, 1, At, B1); P3_BAR; P3_SCHED;
            P3_LDA(At, 0, 2); P3_STAGE_A(P3_SA(0, 0), a2, 0); P3_STAGE_A(P3_SA(0, 1), a2 + third, 1);
            P3_WAIT_V(8); P3_WAIT_L(0); P3_BAR; P3_MMA(2, 0, At, B0); P3_MMA(2, 1, At, B1); P3_BAR; P3_SCHED;
            P3_LDB(B0, 1, 0); P3_LDB(B1, 1, 1); P3_SCHED; P3_LDA(At, 1, 0); P3_STAGE_A(P3_SA(0, 2), a2 + 2 * third, 0);
            P3_WAIT_V(8); P3_WAIT_L(0); P3_BAR; P3_MMA(0, 0, At, B0); P3_MMA(0, 1, At, B1); P3_BAR; P3_SCHED;
            P3_LDA(At, 1, 1); P3_STAGE_B(P3_SB(1, 0), b3); P3_STAGE_B(P3_SB(1, 1), b3 + hstep);
            P3_WAIT_V(8); P3_WAIT_L(0); P3_BAR; P3_MMA(1, 0, At, B0); P3_MMA(1, 1, At, B1); P3_BAR; P3_SCHED;
            P3_LDA(At, 1, 2); P3_STAGE_A(P3_SA(1, 0), a3, 1); P3_STAGE_A(P3_SA(1, 1), a3 + third, 0);
            P3_WAIT_V(8); P3_WAIT_L(0); P3_BAR; P3_MMA(2, 0, At, B0); P3_MMA(2, 1, At, B1); P3_BAR; P3_SCHED;
        }
        if constexpr (ALIGN_EPI) { if (wr == 0) P3_BAR; }
        E(acc, cur, wr, wc, fr, fq);
        if (!has_next) break;
#pragma unroll
        for (int a = 0; a < 3; ++a)
#pragma unroll
            for (int b = 0; b < 2; ++b)
#pragma unroll
                for (int m = 0; m < 3; ++m)
#pragma unroll
                    for (int n = 0; n < 2; ++n) acc[a][b][m][n] = (f32x4){0.f, 0.f, 0.f, 0.f};
        cur = nxt; cA = nA; cB = nB; ++ui;
        if constexpr (ALIGN_EPI) { if (wr == 1) P3_BAR; }
    }
    P3_WAIT_V(0);
    if constexpr (!ALIGN_EPI) { if (wr == 0) P3_BAR; }
    P3_BAR;
#undef P3_SA
#undef P3_SB
#undef P3_GLDS
#undef P3_STAGE_A
#undef P3_STAGE_B
#undef P3_LDA
#undef P3_LDB
#undef P3_MMA
#undef P3_WAIT_V
#undef P3_WAIT_L
#undef P3_BAR
#undef P3_SCHED
}
}

constexpr int NWAVES = 8;
constexpr int DEPTH = 2, DM = 1024, NTP = 16384, NTS = 2048, MTOK = NTP + NTS, NSEQ = 33, NCHUNK = MTOK / 64;
constexpr int PLD = 2816, NINP = 3072, NIN_SRC = 2832, DFF = 4096, NMOD = 6144;
constexpr float EPS = 1e-6f;
constexpr int C_QA = 0, C_KA = 256, C_VA = 512, C_GA = 1024, C_QB = 1536, C_KB = 1792, C_VB = 1920, C_QC = 2048, C_KC = 2304, C_VC = 2560;
constexpr size_t O_Y = 0, O_SGP = 18874368, O_KBP = 18939904, O_VBP = 18972672, O_KCP = 19005440, O_VCP = 19267584, O_SGS = 19529728,
                 O_KBS = 21626880, O_VBS = 22675456, O_KCS = 23724032, O_VCS = 32112640, O_END = 40501248;
constexpr size_t MiB = 1u << 20;
constexpr size_t WS_CTL = 0, CTL_ZERO_BYTES = 1 * MiB;
constexpr size_t WS_MOD = 1 * MiB, WS_BIASM = 3 * MiB, WS_BIASF = 4 * MiB, WS_ROWSQ = 6 * MiB, WS_RA = 8 * MiB, WS_DN = 10 * MiB;
constexpr size_t WS_WIN = 12 * MiB, WS_WOUT = 24 * MiB, WS_WUP = 28 * MiB, WS_WDN = 44 * MiB;
constexpr size_t WS_XN = 60 * MiB;
constexpr size_t WS_PROJ = 96 * MiB;
constexpr size_t WS_MIXED = 195 * MiB;
constexpr size_t WS_SST = 231 * MiB;
constexpr size_t WS_H = 96 * MiB;
constexpr size_t WS_END = 249 * MiB;
constexpr int CW_TMO = 0, CW_CODE = 1, CW_BAR = 4096, CW_Q = 16384;
constexpr int RING_OFF = 0, RING_BYTES = 131072;
constexpr int LDSCTL_OFF = 160 * 1024 - 1024, MISC_OFF = LDSCTL_OFF + 320, TBL_OFF = LDSCTL_OFF + 512;
constexpr int LDS_BYTES = 160 * 1024;

#define GAS __attribute__((address_space(1)))
#define LAS __attribute__((address_space(3)))
typedef unsigned short bf16;
typedef unsigned v4u __attribute__((ext_vector_type(4)));
typedef unsigned v2u __attribute__((ext_vector_type(2)));
typedef float f32x4 __attribute__((ext_vector_type(4)));
typedef GAS unsigned gu32;
#define RLX_AGENT __ATOMIC_RELAXED, __HIP_MEMORY_SCOPE_AGENT
#define LDS_WAIT() asm volatile("s_waitcnt lgkmcnt(0)" ::: "memory")
#define VM_WAIT() asm volatile("s_waitcnt vmcnt(0)" ::: "memory")
__device__ __forceinline__ unsigned f2bf(float f) { unsigned u = __builtin_bit_cast(unsigned, f); return (u + 0x7fffu + ((u >> 16) & 1u)) >> 16; }
__device__ __forceinline__ unsigned pk2(float lo, float hi) { return f2bf(lo) | (f2bf(hi) << 16); }
__device__ __forceinline__ float bf2f(unsigned short h) { return __builtin_bit_cast(float, (unsigned)h << 16); }
__device__ __forceinline__ float bflo(unsigned w) { return __builtin_bit_cast(float, w << 16); }
__device__ __forceinline__ float bfhi(unsigned w) { return __builtin_bit_cast(float, w & 0xffff0000u); }
__device__ __forceinline__ float wave_sum(float v) {
#pragma unroll
    for (int o = 1; o < 64; o <<= 1) v += __shfl_xor(v, o);
    return v;
}
__device__ __forceinline__ float wave_max(float v) {
#pragma unroll
    for (int o = 1; o < 64; o <<= 1) v = fmaxf(v, __shfl_xor(v, o));
    return v;
}
__device__ __forceinline__ float silu_f(float x) { return x / (1.0f + __expf(-x)); }
__device__ __forceinline__ float logsigmoid_f(float x) { return fminf(x, 0.f) - log1pf(__expf(-fabsf(x))); }
#define XB_TMO      128
#define XB_XCNT(j)  (256  + 64 * (j))
#define XB_XSUB(j)  (1280 + 64 * (j))
#define XB_XGEN(j)  (2304 + 64 * (j))
#define XB_TOP      3328
#define XB_TOPGEN   3392
#define XCD_BAR_WORDS 3456
#define XB_SPIN_CAP (1u << 24)

__device__ __forceinline__ unsigned xb_ld(unsigned* p)              { return __hip_atomic_load(p, __ATOMIC_RELAXED, __HIP_MEMORY_SCOPE_AGENT); }
__device__ __forceinline__ unsigned xb_add(unsigned* p, unsigned v) { return __hip_atomic_fetch_add(p, v, __ATOMIC_RELAXED, __HIP_MEMORY_SCOPE_AGENT); }
__device__ __forceinline__ unsigned xb_xcc_id() { return (unsigned)__builtin_amdgcn_s_getreg((3 << 11) | 20) & 0xFu; }
#define XB_SPIN(cond, bar) do { unsigned _sp = 0; while (cond) { __builtin_amdgcn_s_sleep(1); \
    if ((++_sp & 255u) == 0u) { if (xb_ld(&(bar)[XB_TMO])) break; if (_sp > XB_SPIN_CAP) { atomicAdd(&(bar)[XB_TMO], 1u); break; } } } } while (0)

struct XcdBarrier {
    unsigned* bar; unsigned x;
    volatile LAS unsigned* st;
};

__device__ __forceinline__ XcdBarrier xcd_barrier_post(unsigned* bar, volatile LAS unsigned* st) {
    XcdBarrier b; b.bar = bar; b.x = xb_xcc_id(); b.st = st;
    if (threadIdx.x == 0) (void)xb_add(&bar[XB_XCNT(b.x)], 1u);
    return b;
}
__device__ __forceinline__ void xcd_barrier_complete(unsigned* bar, unsigned x, unsigned& nloc, unsigned& nx) {
    const unsigned G = gridDim.x * gridDim.y * gridDim.z;
    unsigned sum, cnt, mine, sp = 0u;
    for (;;) {
        sum = 0u; cnt = 0u; mine = 0u;
#pragma unroll
        for (unsigned j = 0; j < 16; ++j) { const unsigned c = xb_ld(&bar[XB_XCNT(j)]); sum += c; cnt += (c > 0u) ? 1u : 0u; mine = (j == x) ? c : mine; }
        if (sum == G) break;
        __builtin_amdgcn_s_sleep(1);
        if ((++sp & 255u) == 0u) { if (xb_ld(&bar[XB_TMO])) break; if (sp > XB_SPIN_CAP) { atomicAdd(&bar[XB_TMO], 1u); break; } }
    }
    nloc = mine > 0u ? mine : 1u; nx = cnt > 0u ? cnt : 1u;
}

__device__ __forceinline__ void xcd_barrier(const XcdBarrier& b) {
    asm volatile("s_waitcnt vmcnt(0)" ::: "memory");
    __syncthreads();
    if (threadIdx.x == 0) {
        unsigned* bar = b.bar;
        __builtin_amdgcn_s_waitcnt(0);
        unsigned nloc = b.st[0], nx = b.st[1];
        if (nloc == 0u) { xcd_barrier_complete(bar, b.x, nloc, nx); b.st[0] = nloc; b.st[1] = nx; }
        const unsigned old = xb_add(&bar[XB_XSUB(b.x)], 1u);
        const unsigned gen = old / nloc;
        if (old + 1u == (gen + 1u) * nloc) {
            __builtin_amdgcn_fence(__ATOMIC_RELEASE, "agent");
            asm volatile("s_waitcnt vmcnt(0)" ::: "memory");
            const unsigned og = xb_add(&bar[XB_TOP], 1u);
            const unsigned tg = og / nx;
            if (og + 1u == (tg + 1u) * nx) xb_add(&bar[XB_TOPGEN], 1u);
            else XB_SPIN(xb_ld(&bar[XB_TOPGEN]) == tg, bar);
            __builtin_amdgcn_fence(__ATOMIC_ACQUIRE, "agent");
            xb_add(&bar[XB_XGEN(b.x)], 1u);
            asm volatile("s_waitcnt vmcnt(0)" ::: "memory");
        } else {
            XB_SPIN(xb_ld(&bar[XB_XGEN(b.x)]) == gen, bar);
            __builtin_amdgcn_fence(__ATOMIC_ACQUIRE, "agent");
            asm volatile("s_waitcnt vmcnt(0)" ::: "memory");
        }
    }
    __syncthreads();
}

struct Args { const float* in[24]; float* out; unsigned char* ws; int ph_lo, ph_hi; };
static_assert(sizeof(Args) == 24 * 8 + 8 + 8 + 8, "Args has no padding");
__device__ __forceinline__ const float* inp_ptr(LAS unsigned char* lds, int i) {
    const unsigned long long v = ((const volatile LAS unsigned long long*)(lds + TBL_OFF))[i];
    const unsigned lo = __builtin_amdgcn_readfirstlane((unsigned)v), hi = __builtin_amdgcn_readfirstlane((unsigned)(v >> 32));
    return (const float*)(((unsigned long long)hi << 32) | lo);
}
#define INP(i) inp_ptr(F.lds, (i))
struct Frame {
    LAS unsigned char* lds;
    volatile LAS unsigned* MISC;
    gu32* ctl;
    int tid, lane, wave, vcu, G;
    float* out; unsigned char* ws;
};
#define IN_XP 0
#define IN_XS 1
#define IN_CP 2
#define IN_CS 3
#define IN_SG 4
#define IN_CBK 5
#define IN_CBV 6
#define IN_CCK 7
#define IN_CCV 8
#define IN_WADA 9
#define IN_BADA 10
#define IN_GMIX 11
#define IN_GMLP 12
#define IN_WIN 13
#define IN_WA2 14
#define IN_BA2 15
#define IN_ANG 16
#define IN_SINK 17
#define IN_T5 18
#define IN_CREL 19
#define IN_WOUT 20
#define IN_WUP 21
#define IN_WDN 22
#define IN_GFIN 23

__device__ __forceinline__ Frame mkframe(LAS unsigned char* ldsb) {
    Frame F; F.lds = ldsb; F.MISC = (volatile LAS unsigned*)(ldsb + MISC_OFF);
    int tid = threadIdx.x; asm volatile("" : "+v"(tid));
    F.tid = tid; F.lane = tid & 63; F.wave = __builtin_amdgcn_readfirstlane(tid >> 6);
    F.G = gridDim.x; { const int bx = blockIdx.x; F.vcu = (F.G % 8 == 0) ? (bx % 8) * (F.G / 8) + bx / 8 : bx; }
    F.out = (float*)inp_ptr(ldsb, 24); F.ws = (unsigned char*)inp_ptr(ldsb, 25); F.ctl = (gu32*)(F.ws + WS_CTL);
    return F;
}
__device__ __forceinline__ int win_colmap(int n) { return n < 1536 ? n : (n < 2816 ? n + 16 : (n < 2832 ? n - 2816 + 1536 : -1)); }
template <bool WINMAP>
__device__ __forceinline__ void p0_transpose_item(const float* W, int K, int Nsrc, int Npad, bf16* WT, LAS float* scr, int item, int lane) {
    const int nblk = Npad / 32, kb = item / nblk, nb = item % nblk, k0 = 64 * kb, n0 = 32 * nb;
    const int nn = n0 + (lane & 31); const int sc = WINMAP ? win_colmap(nn) : nn;
#pragma unroll 8
    for (int i = 0; i < 32; ++i) { const int kk = 2 * i + (lane >> 5); scr[kk * 33 + (lane & 31)] = (sc >= 0) ? W[(size_t)(k0 + kk) * Nsrc + sc] : 0.f; }
    LDS_WAIT(); asm volatile("" ::: "memory");
    const int c = lane & 7;
#pragma unroll
    for (int j = 0; j < 4; ++j) { const int n = (lane >> 3) + 8 * j; const LAS float* s = scr + (8 * c) * 33 + n;
        v4u o; o.x = pk2(s[0 * 33], s[1 * 33]); o.y = pk2(s[2 * 33], s[3 * 33]); o.z = pk2(s[4 * 33], s[5 * 33]); o.w = pk2(s[6 * 33], s[7 * 33]);
        *(GAS v4u*)(WT + (size_t)(n0 + n) * K + k0 + 8 * c) = o; }
    LDS_WAIT(); asm volatile("" ::: "memory");
}
__device__ __forceinline__ void p0_transposes(Frame& F) {
    LAS float* scr = (LAS float*)(F.lds + RING_OFF + F.wave * 16384);
    const int gw = F.vcu * NWAVES + F.wave, NGW = F.G * NWAVES;
    constexpr int I_IN = 16 * 96, I_OUT = 16 * 32, I_UP = 16 * 128, I_DN = 64 * 32, I_L = I_IN + I_OUT + I_UP + I_DN;
    for (int it = gw; it < DEPTH * I_L; it += NGW) {
        const int l = it / I_L; int r = it % I_L;
        if (r < I_IN) { p0_transpose_item<true>(INP(IN_WIN) + (size_t)l * DM * NIN_SRC, DM, NIN_SRC, NINP, (bf16*)(F.ws + WS_WIN) + (size_t)l * NINP * DM, scr, r, F.lane); continue; } r -= I_IN;
        if (r < I_OUT) { p0_transpose_item<false>(INP(IN_WOUT) + (size_t)l * DM * DM, DM, DM, DM, (bf16*)(F.ws + WS_WOUT) + (size_t)l * DM * DM, scr, r, F.lane); continue; } r -= I_OUT;
        if (r < I_UP) { p0_transpose_item<false>(INP(IN_WUP) + (size_t)l * DM * DFF, DM, DFF, DFF, (bf16*)(F.ws + WS_WUP) + (size_t)l * DFF * DM, scr, r, F.lane); continue; } r -= I_UP;
        p0_transpose_item<false>(INP(IN_WDN) + (size_t)l * DFF * DM, DFF, DM, DM, (bf16*)(F.ws + WS_WDN) + (size_t)l * DM * DFF, scr, r, F.lane);
    }
}
template <int MODE>
__device__ __forceinline__ void skinny_item(Frame& F, int l, int item) {
    LAS float* A = (LAS float*)(F.lds);
    LAS float* RED = (LAS float*)(F.lds + 73728);
    const int n0 = item * 64, col = n0 + F.lane;
    const float* W; int ldw, scol; float* out; int ldo; float addb = 0.f;
    float* MOD = (float*)(F.ws + WS_MOD) + (size_t)l * NSEQ * NMOD;
    if (MODE == 0) { W = INP(IN_WADA) + (size_t)l * DM * NMOD; ldw = NMOD; scol = col; out = MOD; ldo = NMOD; }
    else if (MODE == 1) { W = INP(IN_WIN) + (size_t)l * DM * NIN_SRC; ldw = NIN_SRC; scol = win_colmap(col); out = (float*)(F.ws + WS_BIASM) + (size_t)l * NSEQ * NINP; ldo = NINP; }
    else { W = INP(IN_WUP) + (size_t)l * DM * DFF; ldw = DFF; scol = col; out = (float*)(F.ws + WS_BIASF) + (size_t)l * NSEQ * DFF; ldo = DFF; }
    float acc[36];
#pragma unroll
    for (int s = 0; s < 36; ++s) acc[s] = 0.f;
    for (int kh = 0; kh < 2; ++kh) {
        __syncthreads();
        { const int kk = F.tid, k = 512 * kh + kk;
#pragma unroll 1
          for (int s = 0; s < NSEQ; ++s) { float a;
              if (MODE == 0) { const float c = (s == 0) ? INP(IN_CP)[k] : INP(IN_CS)[(size_t)(s - 1) * DM + k]; a = silu_f(c); }
              else a = MOD[(size_t)s * NMOD + (MODE == 1 ? 0 : 3072) + k];
              A[kk * 36 + s] = a; }
          A[kk * 36 + 33] = 0.f; A[kk * 36 + 34] = 0.f; A[kk * 36 + 35] = 0.f; }
        __syncthreads();
        const int kb = F.wave * 64;
#pragma unroll 4
        for (int kk = kb; kk < kb + 64; ++kk) {
            const float wv = (scol >= 0) ? W[(size_t)(512 * kh + kk) * ldw + scol] : 0.f;
#pragma unroll
            for (int s4 = 0; s4 < 9; ++s4) { const f32x4 a4 = *(const LAS f32x4*)(A + kk * 36 + 4 * s4);
                acc[4 * s4 + 0] += a4[0] * wv; acc[4 * s4 + 1] += a4[1] * wv; acc[4 * s4 + 2] += a4[2] * wv; acc[4 * s4 + 3] += a4[3] * wv; }
        }
    }
#pragma unroll
    for (int s = 0; s < NSEQ; ++s) RED[(F.wave * NSEQ + s) * 64 + F.lane] = acc[s];
    __syncthreads();
    for (int idx = F.tid; idx < NSEQ * 64; idx += NWAVES * 64) { const int s = idx >> 6, ln = idx & 63; float sum = 0.f;
#pragma unroll
        for (int w = 0; w < NWAVES; ++w) sum += RED[(w * NSEQ + s) * 64 + ln];
        if (MODE == 0) sum += INP(IN_BADA)[(size_t)l * NMOD + n0 + ln];
        out[(size_t)s * ldo + n0 + ln] = sum; }
    __syncthreads();
}
__device__ __forceinline__ void xn0_row(Frame& F, int m) {
    const float* xrow = (m < NTP) ? INP(IN_XP) + (size_t)m * DM : INP(IN_XS) + (size_t)(m - NTP) * DM;
    const int s = m < NTP ? 0 : 1 + ((m - NTP) >> 6);
    const float* sc = (const float*)(F.ws + WS_MOD) + (size_t)s * NMOD + 1024; const float* g = INP(IN_GMIX);
    bf16* orow = (bf16*)(F.ws + WS_XN) + (size_t)m * DM;
    float ss = 0.f;
#pragma unroll
    for (int j = 0; j < 4; ++j) { const int c = 4 * (F.lane + 64 * j); const f32x4 v = *(const f32x4*)(xrow + c), gg = *(const f32x4*)(g + c), s4 = *(const f32x4*)(sc + c);
        ss += (v[0] * v[0] + v[1] * v[1]) + (v[2] * v[2] + v[3] * v[3]);
        const f32x4 y = v * (gg * (s4 + 1.0f)); v2u w; w.x = pk2(y[0], y[1]); w.y = pk2(y[2], y[3]); *(v2u*)(orow + c) = w; }
    ss = wave_sum(ss);
    if (F.lane < 16) ((float*)(F.ws + WS_ROWSQ))[(size_t)m * 16 + F.lane] = (F.lane == 0) ? ss : 0.f;
}
__device__ __forceinline__ void final_row(Frame& F, int m) {
    float* xrow = F.out + (size_t)m * DM; const float* g = INP(IN_GFIN);
    const float rs = pg8::rstd_of((const float*)(F.ws + WS_ROWSQ) + (size_t)m * 16);
#pragma unroll
    for (int j = 0; j < 4; ++j) { const int c = 4 * (F.lane + 64 * j); const f32x4 v = *(const f32x4*)(xrow + c), gg = *(const f32x4*)(g + c); *(f32x4*)(xrow + c) = v * rs * gg; }
}

__device__ __forceinline__ int t5_bucket_dev(int rel) {
    const int n = rel < 0 ? -rel : rel; int b;
    if (n < 8) b = n; else { const int lg = 31 - __clz(n * n); int large = 2 + lg; if (large > 15) large = 15; b = large; }
    return (rel > 0 ? 16 : 0) + b;
}
template <int MIX>
__device__ __forceinline__ void attn_simple(Frame& F, int l) {
    constexpr int T0 = MIX ? 8 : 2, NT = T0 + 1, LC = 64 * T0, NKV = MIX ? 4 : 2;
    constexpr int QC = MIX ? C_QC : C_QB, KC = MIX ? C_KC : C_KB, VC = MIX ? C_VC : C_VB, OC = MIX ? 768 : 512;
    const bf16* proj = (const bf16*)(F.ws + WS_PROJ); bf16* mixed = (bf16*)(F.ws + WS_MIXED);
    const float* ck = (MIX ? INP(IN_CCK) : INP(IN_CBK)) + (size_t)l * 32 * LC * NKV * 64; const float* cv = (MIX ? INP(IN_CCV) : INP(IN_CBV)) + (size_t)l * 32 * LC * NKV * 64;
    const float* t5 = INP(IN_T5); const float* crel = INP(IN_CREL) + (size_t)l * 513 * 4; const float* sinkp = INP(IN_SINK) + l * 4;
    const int gw = F.vcu * NWAVES + F.wave, NGW = F.G * NWAVES, lane = F.lane;
    for (int task = gw; task < MTOK * 4; task += NGW) {
        const int m = task >> 2, h = task & 3, kvh = MIX ? h : (h >> 1);
        const bool isp = m < NTP; const int q = m & 63; const int n = m >> 6; const int b = (m - NTP) >> 6;
        const float qd = bf2f(proj[(size_t)m * PLD + QC + 64 * h + lane]);
        LAS float* scl = (LAS float*)(F.lds) + F.wave * 640;
        float mx = -1e30f;
#pragma unroll 1
        for (int i = 0; i < NT; ++i) {
            const int j = lane + 64 * i; float dot = 0.f; bool valid = true;
            if (isp || i == T0) {
                const long tok = isp ? (long)64 * (n - T0) + j : (long)NTP + 64 * b + (j - LC);
                valid = tok >= 0;
                const v4u* kp = (const v4u*)(proj + (size_t)(valid ? tok : 0) * PLD + KC + 64 * kvh);
#pragma unroll 2
                for (int c = 0; c < 8; ++c) { const v4u kv = kp[c];
                    const unsigned w[4] = {kv.x, kv.y, kv.z, kv.w};
#pragma unroll
                    for (int e = 0; e < 4; ++e) { dot += __shfl(qd, 8 * c + 2 * e) * bflo(w[e]); dot += __shfl(qd, 8 * c + 2 * e + 1) * bfhi(w[e]); } }
            } else {
                const f32x4* kp = (const f32x4*)(ck + (((size_t)b * LC + j) * NKV + kvh) * 64);
#pragma unroll 2
                for (int c = 0; c < 16; ++c) { const f32x4 kv = kp[c];
#pragma unroll
                    for (int e = 0; e < 4; ++e) dot += __shfl(qd, 4 * c + e) * kv[e]; }
            }
            const int rel = j - LC - q; float bias;
            if (MIX) { int rc = rel < -256 ? -256 : (rel > 256 ? 256 : rel); bias = crel[(rc + 256) * 4 + h]; }
            else bias = t5[t5_bucket_dev(rel) * 4 + h];
            const float sv = valid ? dot * 0.125f + bias : -1e30f;
            scl[j] = sv; mx = fmaxf(mx, sv);
        }
        mx = wave_max(mx);
        float sk = 0.f; if (!MIX) { sk = sinkp[h]; mx = fmaxf(mx, sk); }
        float sum = 0.f;
#pragma unroll 1
        for (int i = 0; i < NT; ++i) { const float p = __expf(scl[lane + 64 * i] - mx); scl[lane + 64 * i] = p; sum += p; }
        sum = wave_sum(sum); if (!MIX) sum += __expf(sk - mx);
        const float inv = 1.0f / sum;
        LDS_WAIT();
        float o = 0.f;
#pragma unroll 1
        for (int i = 0; i < NT; ++i) {
            if (isp || i == T0) {
                const long tok0 = isp ? (long)64 * (n - T0 + i) : (long)NTP + 64 * b;
                if (tok0 >= 0) {
                    const bf16* vp = proj + (size_t)tok0 * PLD + VC + 64 * kvh + lane;
#pragma unroll 8
                    for (int jj = 0; jj < 64; ++jj) o += scl[64 * i + jj] * bf2f(vp[(size_t)jj * PLD]);
                }
            } else {
                const float* vp = cv + (((size_t)b * LC + 64 * i) * NKV + kvh) * 64 + lane;
#pragma unroll 8
                for (int jj = 0; jj < 64; ++jj) o += scl[64 * i + jj] * vp[(size_t)jj * NKV * 64];
            }
        }
        LDS_WAIT();
        mixed[(size_t)m * DM + OC + 64 * h + lane] = (bf16)f2bf(o * inv);
    }
}
__device__ __forceinline__ void cache_out_simple(Frame& F, int l) {
    const bf16* proj = (const bf16*)(F.ws + WS_PROJ);
    const size_t gt = (size_t)F.vcu * NWAVES * 64 + F.tid, NGT = (size_t)F.G * NWAVES * 64;
    for (size_t i = gt; i < 2 * 16384; i += NGT) { const int kv = (int)(i / 16384), e = (int)(i % 16384), row = e / 128, c = e % 128;
        F.out[(kv ? O_VBP : O_KBP) + (size_t)l * 16384 + e] = bf2f(proj[(size_t)(NTP - 128 + row) * PLD + (kv ? C_VB : C_KB) + c]); }
    for (size_t i = gt; i < 2 * 131072; i += NGT) { const int kv = (int)(i / 131072), e = (int)(i % 131072), row = e / 256, c = e % 256;
        F.out[(kv ? O_VCP : O_KCP) + (size_t)l * 131072 + e] = bf2f(proj[(size_t)(NTP - 512 + row) * PLD + (kv ? C_VC : C_KC) + c]); }
    for (size_t i = gt; i < 2 * 524288; i += NGT) { const int kv = (int)(i / 524288), e = (int)(i % 524288), b = e / 16384, row = (e % 16384) / 128, c = e % 128;
        float v;
        if (row < 64) v = (kv ? INP(IN_CBV) : INP(IN_CBK))[(size_t)l * 524288 + (size_t)b * 16384 + (size_t)(row + 64) * 128 + c];
        else v = bf2f(proj[(size_t)(NTP + 64 * b + row - 64) * PLD + (kv ? C_VB : C_KB) + c]);
        F.out[(kv ? O_VBS : O_KBS) + (size_t)l * 524288 + e] = v; }
    for (size_t i = gt; i < 2 * 4194304; i += NGT) { const int kv = (int)(i / 4194304), e = (int)(i % 4194304), b = e / 131072, row = (e % 131072) / 256, c = e % 256;
        float v;
        if (row < 448) v = (kv ? INP(IN_CCV) : INP(IN_CCK))[(size_t)l * 4194304 + (size_t)b * 131072 + (size_t)(row + 64) * 256 + c];
        else v = bf2f(proj[(size_t)(NTP + 64 * b + row - 448) * PLD + (kv ? C_VC : C_KC) + c]);
        F.out[(kv ? O_VCS : O_KCS) + (size_t)l * 4194304 + e] = v; }
}
__device__ __forceinline__ void gla_simple(Frame& F, int l) {
    const bf16* proj = (const bf16*)(F.ws + WS_PROJ); const float* RA = (const float*)(F.ws + WS_RA); float* OG = (float*)(F.ws + WS_XN);
    const int gw = F.vcu * NWAVES + F.wave, NGW = F.G * NWAVES, lane = F.lane;
    for (int task = gw; task < NSEQ * 512; task += NGW) {
        const int s = task / 512, h = (task % 512) / 128, dv = task % 128;
        const int row0 = s == 0 ? 0 : NTP + 64 * (s - 1), nrow = s == 0 ? NTP : 64;
        float S = s == 0 ? 0.f : INP(IN_SG)[((((size_t)l * 32 + (s - 1)) * 4 + h) * 64 + lane) * 128 + dv];
        float wc[16];
#pragma unroll
        for (int r = 0; r < 16; ++r) wc[r] = INP(IN_WA2)[((size_t)l * 16 + r) * 256 + h * 64 + lane];
        const float ba = INP(IN_BA2)[(size_t)l * 256 + h * 64 + lane];
#pragma unroll 4
        for (int t = 0; t < nrow; ++t) {
            const int m = row0 + t; const float* ra = RA + (size_t)m * 16;
            float x = ba;
#pragma unroll
            for (int r = 0; r < 16; ++r) x += ra[r] * wc[r];
            const float alpha = __expf(logsigmoid_f(x) * (1.0f / 16.0f));
            const float qv = bf2f(proj[(size_t)m * PLD + C_QA + 64 * h + lane]) * 0.125f, kv = bf2f(proj[(size_t)m * PLD + C_KA + 64 * h + lane]);
            const float vv = bf2f(proj[(size_t)m * PLD + C_VA + 128 * h + dv]);
            S = alpha * S + kv * vv;
            const float o = wave_sum(qv * S);
            if (lane == 0) OG[(size_t)m * 512 + h * 128 + dv] = o;
        }
        float* so = F.out + (s == 0 ? O_SGP + (size_t)l * 32768 : O_SGS + ((size_t)l * 32 + (s - 1)) * 32768);
        so[((size_t)h * 64 + lane) * 128 + dv] = S;
    }
}
__device__ __forceinline__ void gla_norm_simple(Frame& F, int l) {
    const bf16* proj = (const bf16*)(F.ws + WS_PROJ); const float* OG = (const float*)(F.ws + WS_XN); bf16* mixed = (bf16*)(F.ws + WS_MIXED);
    const float* ng = INP(IN_ANG) + l * 128;
    const int gw = F.vcu * NWAVES + F.wave, NGW = F.G * NWAVES, lane = F.lane;
    for (int task = gw; task < MTOK * 4; task += NGW) {
        const int m = task >> 2, h = task & 3;
        const float o0 = OG[(size_t)m * 512 + h * 128 + lane], o1 = OG[(size_t)m * 512 + h * 128 + 64 + lane];
        const float ss = wave_sum(o0 * o0 + o1 * o1); const float rs = 1.0f / sqrtf(ss * (1.0f / 128.0f) + EPS);
        const float g0 = bf2f(proj[(size_t)m * PLD + C_GA + 128 * h + lane]), g1 = bf2f(proj[(size_t)m * PLD + C_GA + 128 * h + 64 + lane]);
        mixed[(size_t)m * DM + h * 128 + lane] = (bf16)f2bf(o0 * rs * ng[lane] * silu_f(g0));
        mixed[(size_t)m * DM + h * 128 + 64 + lane] = (bf16)f2bf(o1 * rs * ng[64 + lane] * silu_f(g1));
    }
}

typedef short bf16x8v __attribute__((ext_vector_type(8)));
typedef short s16x4v __attribute__((ext_vector_type(4)));
typedef float f32x16 __attribute__((ext_vector_type(16)));
constexpr int AT_K = 0, AT_V = 36864, AT_BTC = 86016, AT_BTB = 96256, AT_WS = 100352, AT_QW = 102400;
constexpr float LOG2E = 1.4426950408889634f;
__device__ __forceinline__ int crow16(int r, int hi) { return (r & 3) + 8 * (r >> 2) + 4 * hi; }
__device__ __forceinline__ s16x4v ds_tr16(const LAS unsigned char* p) { return __builtin_bit_cast(s16x4v, __builtin_amdgcn_ds_read_tr16_b64_v4i16((LAS s16x4v*)p)); }
__device__ __forceinline__ unsigned cvtpk(float lo, float hi) { unsigned r; asm volatile("v_cvt_pk_bf16_f32 %0, %1, %2" : "=v"(r) : "v"(lo), "v"(hi)); return r; }

__device__ __forceinline__ void attn_build_tables(Frame& F, int l) {
    const float* crel = INP(IN_CREL) + (size_t)l * 513 * 4; const float* t5 = INP(IN_T5);
    LAS float* bc = (LAS float*)(F.lds + AT_BTC); LAS float* bb = (LAS float*)(F.lds + AT_BTB);
    for (int i = F.tid; i < 4 * 640; i += NWAVES * 64) { const int h = i / 640, idx = i % 640; int rel = idx - 575; rel = rel < -256 ? -256 : (rel > 256 ? 256 : rel); bc[i] = crel[(rel + 256) * 4 + h] * LOG2E; }
    for (int i = F.tid; i < 4 * 256; i += NWAVES * 64) { const int h = i / 256, idx = i % 256; bb[i] = t5[t5_bucket_dev(idx - 191) * 4 + h] * LOG2E; }
    __syncthreads();
}

template <int MIX>
__device__ __forceinline__ void attn_unit(Frame& F, int l, int n) {
    constexpr int T0 = MIX ? 8 : 2, NKV = MIX ? 4 : 2, NCH = 8 * NKV, LC = 64 * T0, RP = NKV * 64;
    constexpr int QC = MIX ? C_QC : C_QB, KC = MIX ? C_KC : C_KB, VC = MIX ? C_VC : C_VB, OC = MIX ? 768 : 512;
    constexpr float C2 = 0.125f * LOG2E;
    const bf16* proj = (const bf16*)(F.ws + WS_PROJ); bf16* mixed = (bf16*)(F.ws + WS_MIXED);
    const int tid = F.tid, lane = F.lane, wave = F.wave, head = wave >> 1, qh = wave & 1, kvh = MIX ? head : (head >> 1), r32 = lane & 31, hi = lane >> 5;
    const bool isp = n < 256; const int b = n - 256; const int row0 = isp ? 64 * n : NTP + 64 * b;
    bf16x8v qf[4];
    { const bf16* qp = proj + (size_t)(row0 + 32 * qh + r32) * PLD + QC + 64 * head + 8 * hi;
#pragma unroll
      for (int d0 = 0; d0 < 4; ++d0) qf[d0] = *(const bf16x8v*)(qp + 16 * d0); }
    float m_run, l_run; f32x16 o0, o1;
#pragma unroll
    for (int r = 0; r < 16; ++r) { o0[r] = 0.f; o1[r] = 0.f; }
    if (MIX) { m_run = -1e30f; l_run = 0.f; } else { m_run = INP(IN_SINK)[l * 4 + head] * LOG2E; l_run = (hi == 0) ? 1.f : 0.f; }
    LAS float* wsf = (LAS float*)(F.lds + AT_WS) + wave * 64;
    const LAS float* BT = (const LAS float*)(F.lds + (MIX ? AT_BTC : AT_BTB)) + head * (MIX ? 640 : 256);
    const LAS unsigned char* Kb = F.lds + AT_K + kvh * 9216 + r32 * 144 + hi * 16;
    const LAS unsigned char* Vb = F.lds + AT_V + kvh * 12288 + (4 * hi + ((lane & 15) >> 2)) * 192 + ((lane >> 4) & 1) * 32 + (lane & 3) * 8;
    const float* cki = (MIX ? INP(IN_CCK) : INP(IN_CBK)) + ((size_t)l * 32 + (isp ? 0 : b)) * LC * RP;
    const float* cvi = (MIX ? INP(IN_CCV) : INP(IN_CBV)) + ((size_t)l * 32 + (isp ? 0 : b)) * LC * RP;
    float* oko = F.out + (isp ? (MIX ? O_KCP : O_KBP) + (size_t)l * LC * RP : (MIX ? O_KCS : O_KBS) + ((size_t)l * 32 + b) * LC * RP);
    float* ovo = F.out + (isp ? (MIX ? O_VCP : O_VBP) + (size_t)l * LC * RP : (MIX ? O_VCS : O_VBS) + ((size_t)l * 32 + b) * LC * RP);

#define ATT_COMPUTE(t_) do { \
        f32x16 p0, p1; \
        _Pragma("unroll") for (int r = 0; r < 16; ++r) { p0[r] = 0.f; p1[r] = 0.f; } \
        _Pragma("unroll") for (int d0 = 0; d0 < 4; ++d0) { \
            const bf16x8v kf0 = *(const LAS bf16x8v*)(Kb + d0 * 32), kf1 = *(const LAS bf16x8v*)(Kb + 32 * 144 + d0 * 32); \
            p0 = __builtin_amdgcn_mfma_f32_32x32x16_bf16(kf0, qf[d0], p0, 0, 0, 0); p1 = __builtin_amdgcn_mfma_f32_32x32x16_bf16(kf1, qf[d0], p1, 0, 0, 0); } \
        const int bi = 64 * (t_) + 63 - (32 * qh + r32) + 4 * hi; float tmax = -1e30f; \
        _Pragma("unroll") for (int r = 0; r < 16; ++r) { const int k = (r & 3) + 8 * (r >> 2); \
            p0[r] = p0[r] * C2 + BT[bi + k]; p1[r] = p1[r] * C2 + BT[bi + k + 32]; tmax = fmaxf(tmax, fmaxf(p0[r], p1[r])); } \
        tmax = fmaxf(tmax, __shfl_xor(tmax, 32)); \
        const float mnew = fmaxf(m_run, tmax), alpha = __builtin_amdgcn_exp2f(m_run - mnew); m_run = mnew; \
        float ps = 0.f; \
        _Pragma("unroll") for (int r = 0; r < 16; ++r) { p0[r] = __builtin_amdgcn_exp2f(p0[r] - mnew); p1[r] = __builtin_amdgcn_exp2f(p1[r] - mnew); ps += p0[r] + p1[r]; } \
        l_run = l_run * alpha + ps; \
        if (!__all(alpha == 1.0f)) { if (hi == 0) wsf[r32] = alpha; \
            _Pragma("unroll") for (int r = 0; r < 16; ++r) { const float a = wsf[crow16(r, hi)]; o0[r] *= a; o1[r] *= a; } } \
        bf16x8v pa[4]; \
        { v4u w; w.x = cvtpk(p0[0], p0[1]); w.y = cvtpk(p0[2], p0[3]); w.z = cvtpk(p0[4], p0[5]); w.w = cvtpk(p0[6], p0[7]); pa[0] = __builtin_bit_cast(bf16x8v, w); \
          w.x = cvtpk(p0[8], p0[9]); w.y = cvtpk(p0[10], p0[11]); w.z = cvtpk(p0[12], p0[13]); w.w = cvtpk(p0[14], p0[15]); pa[1] = __builtin_bit_cast(bf16x8v, w); \
          w.x = cvtpk(p1[0], p1[1]); w.y = cvtpk(p1[2], p1[3]); w.z = cvtpk(p1[4], p1[5]); w.w = cvtpk(p1[6], p1[7]); pa[2] = __builtin_bit_cast(bf16x8v, w); \
          w.x = cvtpk(p1[8], p1[9]); w.y = cvtpk(p1[10], p1[11]); w.z = cvtpk(p1[12], p1[13]); w.w = cvtpk(p1[14], p1[15]); pa[3] = __builtin_bit_cast(bf16x8v, w); } \
        _Pragma("unroll") for (int ks = 0; ks < 4; ++ks) { \
            const s16x4v a0 = ds_tr16(Vb + ks * 16 * 192), a1 = ds_tr16(Vb + ks * 16 * 192 + 8 * 192), c0 = ds_tr16(Vb + ks * 16 * 192 + 64), c1 = ds_tr16(Vb + ks * 16 * 192 + 8 * 192 + 64); \
            const bf16x8v v0 = (bf16x8v){a0[0], a0[1], a0[2], a0[3], a1[0], a1[1], a1[2], a1[3]}, v1 = (bf16x8v){c0[0], c0[1], c0[2], c0[3], c1[0], c1[1], c1[2], c1[3]}; \
            o0 = __builtin_amdgcn_mfma_f32_32x32x16_bf16(pa[ks], v0, o0, 0, 0, 0); o1 = __builtin_amdgcn_mfma_f32_32x32x16_bf16(pa[ks], v1, o1, 0, 0, 0); } \
    } while (0)

    if (!isp) {
        f32x4 kr[2 * NKV], vr[2 * NKV];
#define ATT_LOADF(t_) do { _Pragma("unroll") for (int i = 0; i < NKV; ++i) { const int ci = tid + 512 * i, row = ci / NCH, cc = ci % NCH; \
            unsigned off = (unsigned)((64 * (t_) + row) * RP + cc * 8); asm volatile("" : "+v"(off)); \
            const float* kp = cki + off; const float* vp = cvi + off; \
            kr[2 * i] = *(const f32x4*)kp; kr[2 * i + 1] = *(const f32x4*)(kp + 4); vr[2 * i] = *(const f32x4*)vp; vr[2 * i + 1] = *(const f32x4*)(vp + 4); } } while (0)
        for (int t = 0; t < T0; ++t) {
            __syncthreads();
            ATT_LOADF(t);
#pragma unroll
            for (int i = 0; i < NKV; ++i) { const int ci = tid + 512 * i, row = ci / NCH, cc = ci % NCH, hd = cc >> 3, c8 = cc & 7;
                v4u kw, vw; kw.x = pk2(kr[2 * i][0], kr[2 * i][1]); kw.y = pk2(kr[2 * i][2], kr[2 * i][3]); kw.z = pk2(kr[2 * i + 1][0], kr[2 * i + 1][1]); kw.w = pk2(kr[2 * i + 1][2], kr[2 * i + 1][3]);
                vw.x = pk2(vr[2 * i][0], vr[2 * i][1]); vw.y = pk2(vr[2 * i][2], vr[2 * i][3]); vw.z = pk2(vr[2 * i + 1][0], vr[2 * i + 1][1]); vw.w = pk2(vr[2 * i + 1][2], vr[2 * i + 1][3]);
                *(LAS v4u*)(F.lds + AT_K + hd * 9216 + row * 144 + c8 * 16) = kw; *(LAS v4u*)(F.lds + AT_V + hd * 12288 + row * 192 + c8 * 16) = vw;
                if (t >= 1) { unsigned off = (unsigned)((64 * (t - 1) + row) * RP + cc * 8); asm volatile("" : "+v"(off)); float* ok = oko + off; float* ov = ovo + off;
                    *(f32x4*)ok = kr[2 * i]; *(f32x4*)(ok + 4) = kr[2 * i + 1]; *(f32x4*)ov = vr[2 * i]; *(f32x4*)(ov + 4) = vr[2 * i + 1]; } }
            __syncthreads();
            ATT_COMPUTE(t);
        }
#undef ATT_LOADF
    }
    {
        const int tb = isp ? (T0 - n > 0 ? T0 - n : 0) : T0;
        v4u kr[NKV], vr[NKV];
#define ATT_LOADB(t_) do { const int srow = isp ? 64 * (n - T0 + (t_)) : row0; \
        _Pragma("unroll") for (int i = 0; i < NKV; ++i) { const int ci = tid + 512 * i, row = ci / NCH, cc = ci % NCH; \
            unsigned off = (unsigned)((srow + row) * PLD + cc * 8); asm volatile("" : "+v"(off)); \
            kr[i] = *(const v4u*)(proj + off + KC); vr[i] = *(const v4u*)(proj + off + VC); } } while (0)
        const bool wr_out = isp ? (n >= 256 - T0) : true; const int orow0 = isp ? 64 * (n - (256 - T0)) : 64 * (T0 - 1);
        for (int t = tb; t <= T0; ++t) {
            __syncthreads();
            ATT_LOADB(t);
#pragma unroll
            for (int i = 0; i < NKV; ++i) { const int ci = tid + 512 * i, row = ci / NCH, cc = ci % NCH, hd = cc >> 3, c8 = cc & 7;
                *(LAS v4u*)(F.lds + AT_K + hd * 9216 + row * 144 + c8 * 16) = kr[i]; *(LAS v4u*)(F.lds + AT_V + hd * 12288 + row * 192 + c8 * 16) = vr[i];
                if (t == T0 && wr_out) { unsigned off = (unsigned)((orow0 + row) * RP + cc * 8); asm volatile("" : "+v"(off)); float* ok = oko + off; float* ov = ovo + off;
                    *(f32x4*)ok = (f32x4){bflo(kr[i].x), bfhi(kr[i].x), bflo(kr[i].y), bfhi(kr[i].y)}; *(f32x4*)(ok + 4) = (f32x4){bflo(kr[i].z), bfhi(kr[i].z), bflo(kr[i].w), bfhi(kr[i].w)};
                    *(f32x4*)ov = (f32x4){bflo(vr[i].x), bfhi(vr[i].x), bflo(vr[i].y), bfhi(vr[i].y)}; *(f32x4*)(ov + 4) = (f32x4){bflo(vr[i].z), bfhi(vr[i].z), bflo(vr[i].w), bfhi(vr[i].w)}; } }
            __syncthreads();
            ATT_COMPUTE(t);
        }
#undef ATT_LOADB
    }
#undef ATT_COMPUTE
    { const float lt = l_run + __shfl_xor(l_run, 32); if (hi == 0) wsf[r32] = 1.0f / lt; }
    __syncthreads();
    { LAS bf16* stg = (LAS bf16*)(F.lds + AT_K) + wave * 2048;
#pragma unroll
      for (int r = 0; r < 16; ++r) { const int q = crow16(r, hi); const float a = wsf[q];
          stg[q * 64 + r32] = (bf16)f2bf(o0[r] * a); stg[q * 64 + 32 + r32] = (bf16)f2bf(o1[r] * a); }
      LDS_WAIT();
#pragma unroll
      for (int i = 0; i < 4; ++i) { const int row = i * 8 + (lane >> 3), ch = lane & 7; const v4u v = *(const LAS v4u*)(stg + row * 64 + ch * 8);
          *(v4u*)(mixed + (size_t)(row0 + 32 * qh + row) * DM + OC + 64 * head + ch * 8) = v; } }
}
template <int NGLA>
__device__ __forceinline__ void mix1_phase(Frame& F, int l, int rep);

constexpr int GL_RA = 0, GL_TOT = 4096, GL_KH = 6144, GL_V = 18432;
constexpr int G3_Q = 0, G3_K = 9216, G3_V = 18432, G3_S = 38912, G3_O = 59392;

__device__ __forceinline__ void gla_local_unit(Frame& F, int l, int n, int h) {
    bf16* proj = (bf16*)(F.ws + WS_PROJ); const float* RAg = (const float*)(F.ws + WS_RA);
    float* UB = (float*)(F.ws + WS_XN); float* DN = (float*)(F.ws + WS_DN);
    const int tid = F.tid, lane = F.lane, wave = F.wave, row0 = 64 * n, dk = tid & 63, g = tid >> 6, hi = lane >> 5;
    __syncthreads();
    if (tid < 256) { const f32x4 v = *(const f32x4*)(RAg + (size_t)row0 * 16 + tid * 4); *(LAS f32x4*)(F.lds + GL_RA + tid * 16) = v; }
#pragma unroll
    for (int i = 0; i < 2; ++i) { const int ci = tid + 512 * i, row = ci >> 4, c16 = ci & 15;
        const v4u v = *(const v4u*)(proj + (size_t)(row0 + row) * PLD + C_VA + 128 * h + c16 * 8); *(LAS v4u*)(F.lds + GL_V + row * 320 + c16 * 16) = v; }
    float wc[16];
    { const float* wa = INP(IN_WA2) + (size_t)l * 16 * 256 + h * 64 + dk;
#pragma unroll
      for (int r = 0; r < 16; ++r) wc[r] = wa[r * 256]; }
    const float ba = INP(IN_BA2)[(size_t)l * 256 + h * 64 + dk];
    float qv[8], kv[8];
#pragma unroll
    for (int i = 0; i < 8; ++i) { const size_t m = (size_t)(row0 + 8 * g + i) * PLD; qv[i] = bf2f(proj[m + C_QA + 64 * h + dk]); kv[i] = bf2f(proj[m + C_KA + 64 * h + dk]); }
    __syncthreads();
    float c[8]; float run = 0.f;
#pragma unroll
    for (int i = 0; i < 8; ++i) { const int t = 8 * g + i; float x = ba;
#pragma unroll
        for (int r4 = 0; r4 < 4; ++r4) { const f32x4 a = *(const LAS f32x4*)(F.lds + GL_RA + t * 64 + r4 * 16);
            x += a[0] * wc[4 * r4] + a[1] * wc[4 * r4 + 1] + a[2] * wc[4 * r4 + 2] + a[3] * wc[4 * r4 + 3]; }
        run += logsigmoid_f(x) * (1.0f / 16.0f); c[i] = run; }
    ((LAS float*)(F.lds + GL_TOT))[g * 64 + dk] = run;
    __syncthreads();
    float off = 0.f, blast = 0.f;
#pragma unroll
    for (int g2 = 0; g2 < 8; ++g2) { const float tv = ((const LAS float*)(F.lds + GL_TOT))[g2 * 64 + dk]; blast += tv; if (g2 < g) off += tv; }
#pragma unroll
    for (int i = 0; i < 8; ++i) { const float b = off + c[i]; const size_t m = (size_t)(row0 + 8 * g + i) * PLD;
        proj[m + C_QA + 64 * h + dk] = (bf16)f2bf(qv[i] * __expf(b) * 0.125f);
        proj[m + C_KA + 64 * h + dk] = (bf16)f2bf(kv[i] * __expf(-b));
        ((LAS bf16*)(F.lds + GL_KH))[(8 * g + i) * 96 + dk] = (bf16)f2bf(kv[i] * __expf(blast - b)); }
    if (g == 0) DN[((size_t)n * 4 + h) * 64 + dk] = __expf(blast);
    __syncthreads();
    { const int dkh = wave & 1, dvq = wave >> 1; f32x16 acc;
#pragma unroll
      for (int r = 0; r < 16; ++r) acc[r] = 0.f;
      const int rsel = 4 * hi + ((lane & 15) >> 2), csel = ((lane >> 4) & 1) * 32 + (lane & 3) * 8;
      const LAS unsigned char* Ab = F.lds + GL_KH + rsel * 192 + dkh * 64 + csel;
      const LAS unsigned char* Bb = F.lds + GL_V + rsel * 320 + dvq * 64 + csel;
#pragma unroll
      for (int ks = 0; ks < 4; ++ks) {
          const s16x4v a0 = ds_tr16(Ab + ks * 16 * 192), a1 = ds_tr16(Ab + ks * 16 * 192 + 8 * 192), b0 = ds_tr16(Bb + ks * 16 * 320), b1 = ds_tr16(Bb + ks * 16 * 320 + 8 * 320);
          const bf16x8v av = (bf16x8v){a0[0], a0[1], a0[2], a0[3], a1[0], a1[1], a1[2], a1[3]}, bv = (bf16x8v){b0[0], b0[1], b0[2], b0[3], b1[0], b1[1], b1[2], b1[3]};
          acc = __builtin_amdgcn_mfma_f32_32x32x16_bf16(av, bv, acc, 0, 0, 0); }
      float* up = UB + (((size_t)n * 4 + h) * 64 + 32 * dkh) * 128 + 32 * dvq + (lane & 31);
#pragma unroll
      for (int r = 0; r < 16; ++r) up[(size_t)crow16(r, hi) * 128] = acc[r]; }
}

__device__ __forceinline__ void gla_scan(Frame& F, int l) {
    const float* UB = (const float*)(F.ws + WS_XN); const float* DN = (const float*)(F.ws + WS_DN); bf16* SST = (bf16*)(F.ws + WS_SST);
    const int G = F.G, wg = blockIdx.x, tid = F.tid;
    for (int it = wg; it < 64; it += G) { const int e = it * 512 + tid, hd = e >> 7; float S = 0.f;
#pragma unroll 8
        for (int n = 0; n < 256; ++n) { const size_t idx = (size_t)n * 32768 + e; SST[idx] = (bf16)f2bf(S); S = DN[n * 256 + hd] * S + UB[idx]; }
        F.out[O_SGP + (size_t)l * 32768 + e] = S; }
    const int first = G > 64 ? 64 : 0, nw = G - first;
    if (wg >= first) { const float* sg = INP(IN_SG);
        for (int j = wg - first; j < 2048; j += nw) { const int b = j >> 6, e = (j & 63) * 512 + tid, n = 256 + b; const size_t idx = (size_t)n * 32768 + e;
            const float Sin = sg[((size_t)l * 32 + b) * 32768 + e]; SST[idx] = (bf16)f2bf(Sin);
            F.out[O_SGS + ((size_t)l * 32 + b) * 32768 + e] = DN[n * 256 + (e >> 7)] * Sin + UB[idx]; } }
}

__device__ __forceinline__ void gla_out_unit(Frame& F, int l, int n, int h) {
    const bf16* proj = (const bf16*)(F.ws + WS_PROJ); const bf16* SST = (const bf16*)(F.ws + WS_SST); bf16* mixed = (bf16*)(F.ws + WS_MIXED);
    const int tid = F.tid, lane = F.lane, wave = F.wave, row0 = 64 * n, r32 = lane & 31, hi = lane >> 5;
    __syncthreads();
    { const int row = tid >> 3, c8 = tid & 7;
      *(LAS v4u*)(F.lds + G3_Q + row * 144 + c8 * 16) = *(const v4u*)(proj + (size_t)(row0 + row) * PLD + C_QA + 64 * h + c8 * 8);
      *(LAS v4u*)(F.lds + G3_K + row * 144 + c8 * 16) = *(const v4u*)(proj + (size_t)(row0 + row) * PLD + C_KA + 64 * h + c8 * 8); }
#pragma unroll
    for (int i = 0; i < 2; ++i) { const int ci = tid + 512 * i, row = ci >> 4, c16 = ci & 15;
        *(LAS v4u*)(F.lds + G3_V + row * 320 + c16 * 16) = *(const v4u*)(proj + (size_t)(row0 + row) * PLD + C_VA + 128 * h + c16 * 8);
        *(LAS v4u*)(F.lds + G3_S + row * 320 + c16 * 16) = *(const v4u*)(SST + (((size_t)n * 4 + h) * 64 + row) * 128 + c16 * 8); }
    __syncthreads();
    { const int th = wave & 1, dq = wave >> 1;
      bf16x8v qf[4];
#pragma unroll
      for (int d0 = 0; d0 < 4; ++d0) qf[d0] = *(const LAS bf16x8v*)(F.lds + G3_Q + (32 * th + r32) * 144 + d0 * 32 + hi * 16);
      f32x16 p0, p1;
#pragma unroll
      for (int r = 0; r < 16; ++r) { p0[r] = 0.f; p1[r] = 0.f; }
#pragma unroll
      for (int d0 = 0; d0 < 4; ++d0) { const bf16x8v kf0 = *(const LAS bf16x8v*)(F.lds + G3_K + r32 * 144 + d0 * 32 + hi * 16), kf1 = *(const LAS bf16x8v*)(F.lds + G3_K + (32 + r32) * 144 + d0 * 32 + hi * 16);
          p0 = __builtin_amdgcn_mfma_f32_32x32x16_bf16(kf0, qf[d0], p0, 0, 0, 0); p1 = __builtin_amdgcn_mfma_f32_32x32x16_bf16(kf1, qf[d0], p1, 0, 0, 0); }
      const int tabs = 32 * th + r32;
#pragma unroll
      for (int r = 0; r < 16; ++r) { const int s = crow16(r, hi); if (s > tabs) p0[r] = 0.f; if (s + 32 > tabs) p1[r] = 0.f; }
      bf16x8v pa[4];
      { v4u w; w.x = cvtpk(p0[0], p0[1]); w.y = cvtpk(p0[2], p0[3]); w.z = cvtpk(p0[4], p0[5]); w.w = cvtpk(p0[6], p0[7]); pa[0] = __builtin_bit_cast(bf16x8v, w);
        w.x = cvtpk(p0[8], p0[9]); w.y = cvtpk(p0[10], p0[11]); w.z = cvtpk(p0[12], p0[13]); w.w = cvtpk(p0[14], p0[15]); pa[1] = __builtin_bit_cast(bf16x8v, w);
        w.x = cvtpk(p1[0], p1[1]); w.y = cvtpk(p1[2], p1[3]); w.z = cvtpk(p1[4], p1[5]); w.w = cvtpk(p1[6], p1[7]); pa[2] = __builtin_bit_cast(bf16x8v, w);
        w.x = cvtpk(p1[8], p1[9]); w.y = cvtpk(p1[10], p1[11]); w.z = cvtpk(p1[12], p1[13]); w.w = cvtpk(p1[14], p1[15]); pa[3] = __builtin_bit_cast(bf16x8v, w); }
      f32x16 o;
#pragma unroll
      for (int r = 0; r < 16; ++r) o[r] = 0.f;
      const int csel = dq * 64 + ((lane >> 4) & 1) * 32 + (lane & 3) * 8, q4 = (lane & 15) >> 2;
      const LAS unsigned char* Vb = F.lds + G3_V + (4 * hi + q4) * 320 + csel;
      const LAS unsigned char* Sb = F.lds + G3_S + (8 * hi + q4) * 320 + csel;
#pragma unroll
      for (int ks = 0; ks < 4; ++ks) {
          const s16x4v a0 = ds_tr16(Vb + ks * 16 * 320), a1 = ds_tr16(Vb + ks * 16 * 320 + 8 * 320);
          const bf16x8v vv = (bf16x8v){a0[0], a0[1], a0[2], a0[3], a1[0], a1[1], a1[2], a1[3]};
          o = __builtin_amdgcn_mfma_f32_32x32x16_bf16(pa[ks], vv, o, 0, 0, 0); }
#pragma unroll
      for (int ks = 0; ks < 4; ++ks) {
          const s16x4v a0 = ds_tr16(Sb + ks * 16 * 320), a1 = ds_tr16(Sb + ks * 16 * 320 + 4 * 320);
          const bf16x8v sv = (bf16x8v){a0[0], a0[1], a0[2], a0[3], a1[0], a1[1], a1[2], a1[3]};
          o = __builtin_amdgcn_mfma_f32_32x32x16_bf16(qf[ks], sv, o, 0, 0, 0); }
      LAS float* og = (LAS float*)(F.lds + G3_O);
#pragma unroll
      for (int r = 0; r < 16; ++r) og[(32 * th + crow16(r, hi)) * 132 + 32 * dq + r32] = o[r]; }
    __syncthreads();
    { const int t = tid >> 3, seg = tid & 7; const LAS float* og = (const LAS float*)(F.lds + G3_O) + t * 132 + 16 * seg;
      float v[16]; float ss = 0.f;
#pragma unroll
      for (int j4 = 0; j4 < 4; ++j4) { const f32x4 a = *(const LAS f32x4*)(og + 4 * j4); v[4 * j4] = a[0]; v[4 * j4 + 1] = a[1]; v[4 * j4 + 2] = a[2]; v[4 * j4 + 3] = a[3];
          ss += (a[0] * a[0] + a[1] * a[1]) + (a[2] * a[2] + a[3] * a[3]); }
      ss += __shfl_xor(ss, 1); ss += __shfl_xor(ss, 2); ss += __shfl_xor(ss, 4);
      const float rs = 1.0f / sqrtf(ss * (1.0f / 128.0f) + EPS);
      const bf16* gp = proj + (size_t)(row0 + t) * PLD + C_GA + 128 * h + 16 * seg; const float* ng = INP(IN_ANG) + l * 128 + 16 * seg;
      const v4u g0 = *(const v4u*)gp, g1 = *(const v4u*)(gp + 8);
      const unsigned gw[8] = {g0.x, g0.y, g0.z, g0.w, g1.x, g1.y, g1.z, g1.w};
      unsigned ow[8];
#pragma unroll
      for (int j = 0; j < 8; ++j) { const float ga = bflo(gw[j]), gb = bfhi(gw[j]);
          ow[j] = pk2(v[2 * j] * rs * ng[2 * j] * silu_f(ga), v[2 * j + 1] * rs * ng[2 * j + 1] * silu_f(gb)); }
      bf16* op = mixed + (size_t)(row0 + t) * DM + 128 * h + 16 * seg;
      *(v4u*)op = (v4u){ow[0], ow[1], ow[2], ow[3]}; *(v4u*)(op + 8) = (v4u){ow[4], ow[5], ow[6], ow[7]}; }
}
__device__ __forceinline__ void gla_out_phase(Frame& F, int l, int rep) {
    gu32* head = F.ctl + CW_Q + 64 * (3 * l + 2 + 8 * rep);
    volatile LAS unsigned* qw = (volatile LAS unsigned*)(F.lds + AT_QW);
    for (;;) {
        if (F.tid == 0) qw[0] = __hip_atomic_fetch_add(head, 1u, RLX_AGENT);
        __syncthreads();
        const unsigned u = qw[0];
        __syncthreads();
        if (u >= 1152u) break;
        gla_out_unit(F, l, (int)(u >> 2), (int)(u & 3));
    }
}

template <int NGLA>
__device__ __forceinline__ void mix1_phase(Frame& F, int l, int rep) {
    attn_build_tables(F, l);
    volatile LAS unsigned* qw = (volatile LAS unsigned*)(F.lds + AT_QW);
    { gu32* head = F.ctl + CW_Q + 64 * (3 * l + 8 * rep);
      for (;;) {
        if (F.tid == 0) qw[0] = __hip_atomic_fetch_add(head, 1u, RLX_AGENT);
        __syncthreads();
        const unsigned u = qw[0];
        __syncthreads();
        if (u >= 576u) break;
        if (u < 288u) attn_unit<1>(F, l, u < 32u ? 256 + (int)u : (int)u - 32);
        else attn_unit<0>(F, l, u < 320u ? 256 + (int)u - 288 : (int)u - 320);
      } }
    if (NGLA) { gu32* head = F.ctl + CW_Q + 64 * (3 * l + 1);
      for (;;) {
        if (F.tid == 0) qw[0] = __hip_atomic_fetch_add(head, 1u, RLX_AGENT);
        __syncthreads();
        const unsigned u = qw[0];
        __syncthreads();
        if (u >= (unsigned)NGLA) break;
        gla_local_unit(F, l, (int)(u >> 2), (int)(u & 3));
      } }
}

#ifndef PROBE_DUP
#define PROBE_DUP 0
#endif
#ifndef PROBE_BARS
#define PROBE_BARS 0
#endif
#ifndef TILE288
#define TILE288 1
#endif
#ifndef FAST_ATTN
#define FAST_ATTN 1
#endif
#ifndef FAST_GLA
#define FAST_GLA 1
#endif
#ifndef PHMASK
#define PHMASK 1023
#endif
#ifndef MK_ONE_LAUNCH
#define MK_ONE_LAUNCH 1
#endif

#if TILE288
#define GEMM_ORDER pg8::StaticOrder3
#define EPI_PROJ pg8::EpiProj3
#define EPI_UP pg8::EpiUp3
#define EPI_RES pg8::EpiRes3
#define GEMM_RUN(EPI) pg8::gemm_phase288<EPI, pg8::StaticOrder3, true>(F.lds + RING_OFF, g, S, E)
#else
#define GEMM_ORDER pg8::StaticOrder
#define EPI_PROJ pg8::EpiProj
#define EPI_UP pg8::EpiUp
#define EPI_RES pg8::EpiRes
#define GEMM_RUN(EPI) pg8::gemm_phase<EPI, pg8::StaticOrder, true, true>(F.lds + RING_OFF, g, S, E)
#endif
constexpr int PH_P0 = 0, PH_P1 = 1, PH_L0 = 2, PH_PER_LAYER = 7, PH_FINAL = PH_L0 + DEPTH * PH_PER_LAYER, N_PHASES = PH_FINAL + 1;

__global__ void __launch_bounds__(NWAVES * 64, 2) enc_fwd(Args args) {
    extern __shared__ __attribute__((aligned(16))) unsigned char lds[];
    LAS unsigned char* const ldsb = (LAS unsigned char*)lds;
    { int t0 = threadIdx.x;
      for (int u = t0; u < (LDS_BYTES - LDSCTL_OFF) / 4; u += NWAVES * 64) ((LAS unsigned*)(ldsb + LDSCTL_OFF))[u] = 0u;
      __syncthreads();
      if (t0 == 0) { LAS unsigned long long* t = (LAS unsigned long long*)(ldsb + TBL_OFF);
#pragma unroll
          for (int i = 0; i < 24; ++i) t[i] = (unsigned long long)args.in[i];
          t[24] = (unsigned long long)args.out; t[25] = (unsigned long long)args.ws; }
      __syncthreads(); }
#if MK_ONE_LAUNCH
    { const XcdBarrier b0 = xcd_barrier_post((unsigned*)((gu32*)inp_ptr(ldsb, 25) + CW_BAR), (volatile LAS unsigned*)(ldsb + MISC_OFF) + 8); (void)b0; }
#define GRID_BAR() do { XcdBarrier b_; b_.bar = (unsigned*)((gu32*)inp_ptr(ldsb, 25) + CW_BAR); b_.x = xb_xcc_id(); b_.st = (volatile LAS unsigned*)(ldsb + MISC_OFF) + 8; xcd_barrier(b_); } while (0)
#else
#define GRID_BAR() do {} while (0)
#endif
#define IN(k) (args.ph_lo <= (k) && (k) < args.ph_hi)
#define SEAM(k) do { if (IN(k) && IN((k) + 1)) GRID_BAR(); } while (0)
#define PHASE_FRAME() Frame F = mkframe(ldsb); const int gw = F.vcu * NWAVES + F.wave, NGW = F.G * NWAVES; (void)gw; (void)NGW

    if (IN(PH_P0) && (PHMASK & 1)) {
        PHASE_FRAME();
        for (int it = blockIdx.x; it < DEPTH * (NMOD / 64); it += F.G) skinny_item<0>(F, it / (NMOD / 64), it % (NMOD / 64));
        p0_transposes(F);
        if (PROBE_DUP & 1) { GRID_BAR(); for (int it = blockIdx.x; it < DEPTH * (NMOD / 64); it += F.G) skinny_item<0>(F, it / (NMOD / 64), it % (NMOD / 64)); p0_transposes(F); }
        for (int pbx = 0; pbx < PROBE_BARS; ++pbx) GRID_BAR();
    }
    SEAM(PH_P0);
    if (IN(PH_P1) && (PHMASK & 2)) {
        PHASE_FRAME();
        constexpr int NB1 = NINP / 64, NB2 = DFF / 64;
        for (int rep = 0; rep < ((PROBE_DUP & 2) ? 2 : 1); ++rep) {
        if (rep) GRID_BAR();
        for (int it = blockIdx.x; it < DEPTH * (NB1 + NB2); it += F.G) { const int l = it / (NB1 + NB2), r = it % (NB1 + NB2);
            if (r < NB1) skinny_item<1>(F, l, r); else skinny_item<2>(F, l, r - NB1); }
        for (int m = gw; m < MTOK; m += NGW) xn0_row(F, m);
        }
    }
    SEAM(PH_P1);
    { constexpr int l = 0;
        const int pb = PH_L0 + l * PH_PER_LAYER;
        if (IN(pb + 0) && (PHMASK & 4)) {
        PHASE_FRAME();
            pg8::Gemm g{(const bf16*)(F.ws + WS_XN), (const bf16*)(F.ws + WS_WIN) + (size_t)l * NINP * DM, MTOK, NINP, DM}; GEMM_ORDER S; S.init(MTOK, NINP, F.G, (int)blockIdx.x);
            EPI_PROJ E{(bf16*)(F.ws + WS_PROJ), (float*)(F.ws + WS_RA), (const float*)(F.ws + WS_ROWSQ), (const float*)(F.ws + WS_BIASM) + (size_t)l * NSEQ * NINP};
            GEMM_RUN(EPI_PROJ);
            if (PROBE_DUP & 16) { GRID_BAR(); GEMM_RUN(EPI_PROJ); }
        }
        SEAM(pb + 0);
        if (IN(pb + 1) && (PHMASK & 8)) {
        PHASE_FRAME();
#if FAST_ATTN
            if (PROBE_DUP & 4) { mix1_phase<0>(F, l, 1); GRID_BAR(); }
            mix1_phase<FAST_GLA ? 1152 : 0>(F, l, 0);
#else
            attn_simple<1>(F, l); attn_simple<0>(F, l); cache_out_simple(F, l);
#endif
        }
        SEAM(pb + 1);
        if (IN(pb + 2) && (PHMASK & 16)) {
        PHASE_FRAME();
#if FAST_GLA
            gla_scan(F, l);
            if (PROBE_DUP & 8) { GRID_BAR(); gla_scan(F, l); }
#else
            gla_simple(F, l);
#endif
        }
        SEAM(pb + 2);
        if (IN(pb + 3) && (PHMASK & 32)) {
        PHASE_FRAME();
#if FAST_GLA
            gla_out_phase(F, l, 0);
            if (PROBE_DUP & 64) { GRID_BAR(); gla_out_phase(F, l, 1); }
#else
            gla_norm_simple(F, l);
#endif
        }
        SEAM(pb + 3);
        if (IN(pb + 4) && (PHMASK & 64)) {
        PHASE_FRAME();
            pg8::Gemm g{(const bf16*)(F.ws + WS_MIXED), (const bf16*)(F.ws + WS_WOUT) + (size_t)l * DM * DM, MTOK, DM, DM}; GEMM_ORDER S; S.init(MTOK, DM, F.G, (int)blockIdx.x);
            EPI_RES E{l == 0 ? INP(IN_XP) : F.out, l == 0 ? INP(IN_XS) : F.out + (size_t)NTP * DM, F.out, (float*)(F.ws + WS_MOD) + (size_t)l * NSEQ * NMOD + 2048,
                          INP(IN_GMLP) + (size_t)l * DM, (float*)(F.ws + WS_MOD) + (size_t)l * NSEQ * NMOD + 4096, (bf16*)(F.ws + WS_XN), (float*)(F.ws + WS_ROWSQ)};
            GEMM_RUN(EPI_RES);
        }
        SEAM(pb + 4);
        if (IN(pb + 5) && (PHMASK & 128)) {
        PHASE_FRAME();
            pg8::Gemm g{(const bf16*)(F.ws + WS_XN), (const bf16*)(F.ws + WS_WUP) + (size_t)l * DFF * DM, MTOK, DFF, DM}; GEMM_ORDER S; S.init(MTOK, DFF, F.G, (int)blockIdx.x);
            EPI_UP E{(bf16*)(F.ws + WS_H), (const float*)(F.ws + WS_ROWSQ), (const float*)(F.ws + WS_BIASF) + (size_t)l * NSEQ * DFF};
            GEMM_RUN(EPI_UP);
            if (PROBE_DUP & 32) { GRID_BAR(); GEMM_RUN(EPI_UP); }
        }
        SEAM(pb + 5);
        if (IN(pb + 6) && (PHMASK & 256)) {
        PHASE_FRAME();
            pg8::Gemm g{(const bf16*)(F.ws + WS_H), (const bf16*)(F.ws + WS_WDN) + (size_t)l * DM * DFF, MTOK, DM, DFF}; GEMM_ORDER S; S.init(MTOK, DM, F.G, (int)blockIdx.x);
            const bool more = (l + 1 < DEPTH);
            EPI_RES E{F.out, F.out + (size_t)NTP * DM, F.out, (float*)(F.ws + WS_MOD) + (size_t)l * NSEQ * NMOD + 5120,
                          more ? INP(IN_GMIX) + (size_t)(l + 1) * DM : nullptr, (float*)(F.ws + WS_MOD) + (size_t)(l + 1 < DEPTH ? l + 1 : l) * NSEQ * NMOD + 1024, (bf16*)(F.ws + WS_XN), (float*)(F.ws + WS_ROWSQ)};
            GEMM_RUN(EPI_RES);
        }
        SEAM(pb + 6);
        }
    { constexpr int l = 1;
        const int pb = PH_L0 + l * PH_PER_LAYER;
        if (IN(pb + 0) && (PHMASK & 4)) {
        PHASE_FRAME();
            pg8::Gemm g{(const bf16*)(F.ws + WS_XN), (const bf16*)(F.ws + WS_WIN) + (size_t)l * NINP * DM, MTOK, NINP, DM}; GEMM_ORDER S; S.init(MTOK, NINP, F.G, (int)blockIdx.x);
            EPI_PROJ E{(bf16*)(F.ws + WS_PROJ), (float*)(F.ws + WS_RA), (const float*)(F.ws + WS_ROWSQ), (const float*)(F.ws + WS_BIASM) + (size_t)l * NSEQ * NINP};
            GEMM_RUN(EPI_PROJ);
            if (PROBE_DUP & 16) { GRID_BAR(); GEMM_RUN(EPI_PROJ); }
        }
        SEAM(pb + 0);
        if (IN(pb + 1) && (PHMASK & 8)) {
        PHASE_FRAME();
#if FAST_ATTN
            if (PROBE_DUP & 4) { mix1_phase<0>(F, l, 1); GRID_BAR(); }
            mix1_phase<FAST_GLA ? 1152 : 0>(F, l, 0);
#else
            attn_simple<1>(F, l); attn_simple<0>(F, l); cache_out_simple(F, l);
#endif
        }
        SEAM(pb + 1);
        if (IN(pb + 2) && (PHMASK & 16)) {
        PHASE_FRAME();
#if FAST_GLA
            gla_scan(F, l);
            if (PROBE_DUP & 8) { GRID_BAR(); gla_scan(F, l); }
#else
            gla_simple(F, l);
#endif
        }
        SEAM(pb + 2);
        if (IN(pb + 3) && (PHMASK & 32)) {
        PHASE_FRAME();
#if FAST_GLA
            gla_out_phase(F, l, 0);
            if (PROBE_DUP & 64) { GRID_BAR(); gla_out_phase(F, l, 1); }
#else
            gla_norm_simple(F, l);
#endif
        }
        SEAM(pb + 3);
        if (IN(pb + 4) && (PHMASK & 64)) {
        PHASE_FRAME();
            pg8::Gemm g{(const bf16*)(F.ws + WS_MIXED), (const bf16*)(F.ws + WS_WOUT) + (size_t)l * DM * DM, MTOK, DM, DM}; GEMM_ORDER S; S.init(MTOK, DM, F.G, (int)blockIdx.x);
            EPI_RES E{l == 0 ? INP(IN_XP) : F.out, l == 0 ? INP(IN_XS) : F.out + (size_t)NTP * DM, F.out, (float*)(F.ws + WS_MOD) + (size_t)l * NSEQ * NMOD + 2048,
                          INP(IN_GMLP) + (size_t)l * DM, (float*)(F.ws + WS_MOD) + (size_t)l * NSEQ * NMOD + 4096, (bf16*)(F.ws + WS_XN), (float*)(F.ws + WS_ROWSQ)};
            GEMM_RUN(EPI_RES);
        }
        SEAM(pb + 4);
        if (IN(pb + 5) && (PHMASK & 128)) {
        PHASE_FRAME();
            pg8::Gemm g{(const bf16*)(F.ws + WS_XN), (const bf16*)(F.ws + WS_WUP) + (size_t)l * DFF * DM, MTOK, DFF, DM}; GEMM_ORDER S; S.init(MTOK, DFF, F.G, (int)blockIdx.x);
            EPI_UP E{(bf16*)(F.ws + WS_H), (const float*)(F.ws + WS_ROWSQ), (const float*)(F.ws + WS_BIASF) + (size_t)l * NSEQ * DFF};
            GEMM_RUN(EPI_UP);
            if (PROBE_DUP & 32) { GRID_BAR(); GEMM_RUN(EPI_UP); }
        }
        SEAM(pb + 5);
        if (IN(pb + 6) && (PHMASK & 256)) {
        PHASE_FRAME();
            pg8::Gemm g{(const bf16*)(F.ws + WS_H), (const bf16*)(F.ws + WS_WDN) + (size_t)l * DM * DFF, MTOK, DM, DFF}; GEMM_ORDER S; S.init(MTOK, DM, F.G, (int)blockIdx.x);
            const bool more = (l + 1 < DEPTH);
            EPI_RES E{F.out, F.out + (size_t)NTP * DM, F.out, (float*)(F.ws + WS_MOD) + (size_t)l * NSEQ * NMOD + 5120,
                          more ? INP(IN_GMIX) + (size_t)(l + 1) * DM : nullptr, (float*)(F.ws + WS_MOD) + (size_t)(l + 1 < DEPTH ? l + 1 : l) * NSEQ * NMOD + 1024, (bf16*)(F.ws + WS_XN), (float*)(F.ws + WS_ROWSQ)};
            GEMM_RUN(EPI_RES);
        }
        SEAM(pb + 6);
        }
    if (IN(PH_FINAL) && (PHMASK & 512)) { PHASE_FRAME(); for (int m = gw; m < MTOK; m += NGW) final_row(F, m); }
#undef IN
#undef SEAM
}

extern "C" void kernel_launch(void* const* d_in, const int* in_sizes, int n_in, void* d_out, int out_size, void* d_ws, size_t ws_size, hipStream_t stream) {
    static int grid = 0;
    if (grid == 0) {
        if (n_in != 24 || out_size != (int)O_END || ws_size < WS_END) { fprintf(stderr, "kernel_launch: unexpected shapes: n_in %d out %d ws %zu\n", n_in, out_size, ws_size); grid = -1; return; }
        int dev = 0, cus = 0, per_cu = 0;
        if (hipGetDevice(&dev) != hipSuccess || hipDeviceGetAttribute(&cus, hipDeviceAttributeMultiprocessorCount, dev) != hipSuccess) { grid = -1; return; }
        if (hipFuncSetAttribute((const void*)enc_fwd, hipFuncAttributeMaxDynamicSharedMemorySize, LDS_BYTES) != hipSuccess) { fprintf(stderr, "kernel_launch: hipFuncSetAttribute failed\n"); grid = -1; return; }
        if (hipOccupancyMaxActiveBlocksPerMultiprocessor(&per_cu, (const void*)enc_fwd, NWAVES * 64, LDS_BYTES) != hipSuccess || per_cu < 1) { fprintf(stderr, "kernel_launch: occupancy query says %d\n", per_cu); (void)hipGetLastError(); per_cu = 1; }
        grid = cus;
    }
    if (grid < 0) return;
    (void)hipMemsetAsync((char*)d_ws + WS_CTL, 0, CTL_ZERO_BYTES, stream);
    Args a{};
    for (int i = 0; i < 24; ++i) a.in[i] = (const float*)d_in[i];
    a.out = (float*)d_out; a.ws = (unsigned char*)d_ws;
#if MK_ONE_LAUNCH
    a.ph_lo = 0; a.ph_hi = N_PHASES;
    hipLaunchKernelGGL(enc_fwd, dim3(grid), dim3(NWAVES * 64), LDS_BYTES, stream, a);
#else
    for (int p = 0; p < N_PHASES; ++p) { a.ph_lo = p; a.ph_hi = p + 1; hipLaunchKernelGGL(enc_fwd, dim3(grid), dim3(NWAVES * 64), LDS_BYTES, stream, a); }
#endif
}
```
